# Optimizing an MI355X kernel written in HIP

```python
import math
import jax, jax.numpy as jnp
from jax import lax
import numpy as np

D_MODEL = 1024
BATCH = 16
SEQ = 2048
DEPTH = 4

MLA_HEADS = 6
MLA_Q_RANK = 256
MLA_KV_RANK = 128
MLA_NOPE = 64
MLA_ROPE = 32
MLA_V = 64
MLA_WIDTH = MLA_HEADS * MLA_V
ATTN_BLOCK = 128
RET_HEADS = 4
RET_DK = 32
RET_DV = 64
RET_WIDTH = RET_HEADS * RET_DV
RET_CHUNK = 128
LRU_WIDTH = D_MODEL - MLA_WIDTH - RET_WIDTH
LRU_BLOCKS = 6
LRU_BLOCK = LRU_WIDTH // LRU_BLOCKS
CONV_WIDTH = 4
LRU_C = 8.0
MIX_WIDTH = MLA_WIDTH + RET_WIDTH + LRU_WIDTH
FFN_HIDDEN = -(-8 * D_MODEL // (3 * 256)) * 256
IN_COLS = (MLA_Q_RANK, MLA_KV_RANK, MLA_ROPE,
           RET_HEADS * RET_DK, RET_HEADS * RET_DK, RET_WIDTH, RET_WIDTH,
           LRU_WIDTH, LRU_WIDTH)
D_IN = sum(IN_COLS)
ROPE_BASE = 10000.0
NORM_EPS = 1e-6
N_MOD = 6

kernel_name = "hymba_mla_retention_rglru_adaln"


def rms_norm(x, g):
    xf = x.astype(jnp.float32)
    y = xf * lax.rsqrt(jnp.mean(xf * xf, axis=-1, keepdims=True) + NORM_EPS)
    return (y * g.astype(jnp.float32)).astype(x.dtype)


def rotary(x, pos):
    half = x.shape[-1] // 2
    inv = ROPE_BASE ** (-jnp.arange(half, dtype=jnp.float32) / half)
    ang = pos.astype(jnp.float32)[:, None, :, None] * inv
    cos, sin = jnp.cos(ang), jnp.sin(ang)
    xf = x.astype(jnp.float32)
    x1, x2 = xf[..., :half], xf[..., half:]
    return jnp.concatenate([x1 * cos - x2 * sin, x1 * sin + x2 * cos], axis=-1).astype(x.dtype)


def split_cols(z):
    offsets = np.cumsum(np.array(IN_COLS))[:-1].tolist()
    return jnp.split(z, offsets, axis=-1)


def mla(c_q, c_kv, k_rope, pos, q_norm, w_uq, kv_norm, w_ukv):
    B, S, _ = c_q.shape
    H = MLA_HEADS
    q = (rms_norm(c_q, q_norm) @ w_uq).reshape(B, S, H, MLA_NOPE + MLA_ROPE).transpose(0, 2, 1, 3)
    q = jnp.concatenate([q[..., :MLA_NOPE], rotary(q[..., MLA_NOPE:], pos)], axis=-1)
    kv = (rms_norm(c_kv, kv_norm) @ w_ukv).reshape(B, S, H, MLA_NOPE + MLA_V).transpose(0, 2, 1, 3)
    k_nope, v = kv[..., :MLA_NOPE], kv[..., MLA_NOPE:]
    k_r = rotary(k_rope[:, None], pos)
    k = jnp.concatenate([k_nope, jnp.broadcast_to(k_r, (B, H, S, MLA_ROPE))], axis=-1)
    scale = (MLA_NOPE + MLA_ROPE) ** -0.5
    outs = []
    for blk in range(S // ATTN_BLOCK):
        q0 = blk * ATTN_BLOCK
        q1 = q0 + ATTN_BLOCK
        s = jnp.einsum('bhqd,bhkd->bhqk', q[:, :, q0:q1], k[:, :, :q1]).astype(jnp.float32) * scale
        mask = jnp.arange(q1)[None, :] <= jnp.arange(q0, q1)[:, None]
        s = jnp.where(mask, s, -jnp.inf)
        p = jax.nn.softmax(s, axis=-1).astype(v.dtype)
        outs.append(jnp.einsum('bhqk,bhkd->bhqd', p, v[:, :, :q1]))
    o = jnp.concatenate(outs, axis=2)
    return o.transpose(0, 2, 1, 3).reshape(B, S, H * MLA_V)


def retention(q, k, v, g, pos, gn_gain):
    B, S, _ = q.shape
    H, C = RET_HEADS, RET_CHUNK
    N = S // C
    f32 = jnp.float32
    q = rotary(q.reshape(B, S, H, RET_DK).transpose(0, 2, 1, 3), pos).astype(f32)
    k = rotary(k.reshape(B, S, H, RET_DK).transpose(0, 2, 1, 3), pos).astype(f32) * (RET_DK ** -0.5)
    v = v.reshape(B, S, H, RET_DV).transpose(0, 2, 1, 3).astype(f32)
    log_g = jnp.log(1.0 - jnp.exp2(-5.0 - jnp.arange(H, dtype=f32)))
    idx = jnp.arange(C, dtype=f32)
    diff = idx[:, None] - idx[None, :]
    decay = jnp.where(diff >= 0, jnp.exp(log_g[:, None, None] * jnp.maximum(diff, 0.0)), 0.0)
    q_decay = jnp.exp(log_g[:, None] * (idx + 1.0))
    k_decay = jnp.exp(log_g[:, None] * (C - 1.0 - idx))
    chunk_decay = jnp.exp(log_g * C)
    qc = q.reshape(B, H, N, C, RET_DK)
    kc = k.reshape(B, H, N, C, RET_DK)
    vc = v.reshape(B, H, N, C, RET_DV)
    scores = jnp.einsum('bhncd,bhnmd->bhncm', qc, kc) * decay[None, :, None]
    inner = jnp.einsum('bhncm,bhnme->bhnce', scores, vc)
    kv = jnp.einsum('bhnmd,bhnme->nbhde', kc * k_decay[None, :, None, :, None], vc)

    def step(state, kv_n):
        return state * chunk_decay[None, :, None, None] + kv_n, state

    _, states = lax.scan(step, jnp.zeros((B, H, RET_DK, RET_DV), f32), kv)
    cross = jnp.einsum('bhncd,nbhde->bhnce', qc * q_decay[None, :, None, :, None], states)
    o = (inner + cross).reshape(B, H, S, RET_DV)
    mu = jnp.mean(o, axis=-1, keepdims=True)
    var = jnp.mean(jnp.square(o - mu), axis=-1, keepdims=True)
    o = ((o - mu) * lax.rsqrt(var + NORM_EPS)).transpose(0, 2, 1, 3).reshape(B, S, H * RET_DV)
    o = o * gn_gain.astype(f32)
    return (jax.nn.silu(g.astype(f32)) * o).astype(g.dtype)


def rg_lru_block(xb, gb, conv_w, conv_b, w_a, b_a, w_i, b_i, lam):
    B, S, W = xb.shape
    f32 = jnp.float32
    xc = lax.conv_general_dilated(xb, conv_w[:, None, :], window_strides=(1,),
                                  padding=[(CONV_WIDTH - 1, 0)],
                                  dimension_numbers=('NWC', 'WIO', 'NWC'),
                                  feature_group_count=W) + conv_b
    xg = xc.reshape(B, S, LRU_BLOCKS, LRU_BLOCK)
    r = jax.nn.sigmoid(jnp.einsum('bsgi,gij->bsgj', xg, w_a).reshape(B, S, W) + b_a).astype(f32)
    i = jax.nn.sigmoid(jnp.einsum('bsgi,gij->bsgj', xg, w_i).reshape(B, S, W) + b_i).astype(f32)
    log_a = -LRU_C * r * jax.nn.softplus(-lam.astype(f32))
    a = jnp.exp(log_a)
    b = jnp.sqrt(-jnp.expm1(2.0 * log_a)) * i * xc.astype(f32)

    def combine(left, right):
        a1, b1 = left
        a2, b2 = right
        return a1 * a2, a2 * b1 + b2

    _, h = lax.associative_scan(combine, (a, b), axis=1)
    return (jax.nn.gelu(gb.astype(f32)) * h).astype(xb.dtype)


def setup_inputs(seed: int = 0) -> dict:
    key = jax.random.key(seed)
    ks = iter(jax.random.split(key, 40))
    L, D = DEPTH, D_MODEL

    def nrm(shape, scale):
        return jax.random.normal(next(ks), shape, jnp.float32) * scale

    x = nrm((BATCH, SEQ, D), 1.0)
    c = nrm((BATCH, D), 1.0)
    offset = jax.random.randint(next(ks), (BATCH, 1), 0, 1024, dtype=jnp.int32)
    positions = offset + jnp.arange(SEQ, dtype=jnp.int32)[None, :]
    a0 = jax.random.uniform(next(ks), (L, LRU_WIDTH), jnp.float32, 0.9, 0.999)
    return {
        "x": x,
        "c": c,
        "positions": positions,
        "mod_w": nrm((L, D, N_MOD * D), 0.5 * D ** -0.5),
        "mod_b": nrm((L, N_MOD * D), 0.02),
        "norm1": 1.0 + nrm((L, D), 0.02),
        "w_in": nrm((L, D, D_IN), D ** -0.5),
        "mla_q_norm": 1.0 + nrm((L, MLA_Q_RANK), 0.02),
        "mla_w_uq": nrm((L, MLA_Q_RANK, MLA_HEADS * (MLA_NOPE + MLA_ROPE)), MLA_Q_RANK ** -0.5),
        "mla_kv_norm": 1.0 + nrm((L, MLA_KV_RANK), 0.02),
        "mla_w_ukv": nrm((L, MLA_KV_RANK, MLA_HEADS * (MLA_NOPE + MLA_V)), MLA_KV_RANK ** -0.5),
        "ret_gn": 1.0 + nrm((L, RET_WIDTH), 0.02),
        "lru_conv_w": nrm((L, CONV_WIDTH, LRU_WIDTH), CONV_WIDTH ** -0.5),
        "lru_conv_b": nrm((L, LRU_WIDTH), 0.02),
        "lru_w_a": nrm((L, LRU_BLOCKS, LRU_BLOCK, LRU_BLOCK), LRU_BLOCK ** -0.5),
        "lru_b_a": nrm((L, LRU_WIDTH), 0.02),
        "lru_w_i": nrm((L, LRU_BLOCKS, LRU_BLOCK, LRU_BLOCK), LRU_BLOCK ** -0.5),
        "lru_b_i": nrm((L, LRU_WIDTH), 0.02),
        "lru_lambda": jnp.log(a0) - jnp.log1p(-a0),
        "w_out": nrm((L, MIX_WIDTH, D), MIX_WIDTH ** -0.5),
        "norm2": 1.0 + nrm((L, D), 0.02),
        "w_gate_up": nrm((L, D, 2 * FFN_HIDDEN), D ** -0.5),
        "w_down": nrm((L, FFN_HIDDEN, D), FFN_HIDDEN ** -0.5),
        "final_norm": 1.0 + nrm((D,), 0.02),
        "final_mod_w": nrm((D, 2 * D), 0.5 * D ** -0.5),
        "final_mod_b": nrm((2 * D,), 0.02),
    }


def reference(x, c, positions, mod_w, mod_b, norm1, w_in, mla_q_norm, mla_w_uq, mla_kv_norm,
              mla_w_ukv, ret_gn, lru_conv_w, lru_conv_b, lru_w_a, lru_b_a, lru_w_i, lru_b_i,
              lru_lambda, w_out, norm2, w_gate_up, w_down, final_norm, final_mod_w, final_mod_b):
    B = x.shape[0]
    c_act = jax.nn.silu(c)
    for l in range(DEPTH):
        mod = (c_act @ mod_w[l] + mod_b[l]).reshape(B, N_MOD, D_MODEL)[:, :, None, :]
        sh1, sc1, g1, sh2, sc2, g2 = [mod[:, j] for j in range(N_MOD)]
        h = rms_norm(x, norm1[l]) * (1.0 + sc1) + sh1
        c_q, c_kv, k_rope, r_q, r_k, r_v, r_g, u_x, u_g = split_cols(h @ w_in[l])
        y_a = mla(c_q, c_kv, k_rope, positions, mla_q_norm[l], mla_w_uq[l],
                  mla_kv_norm[l], mla_w_ukv[l])
        y_b = retention(r_q, r_k, r_v, r_g, positions, ret_gn[l])
        y_c = rg_lru_block(u_x, u_g, lru_conv_w[l], lru_conv_b[l], lru_w_a[l], lru_b_a[l],
                           lru_w_i[l], lru_b_i[l], lru_lambda[l])
        y = jnp.concatenate([y_a, y_b, y_c], axis=-1) @ w_out[l]
        x = x + g1 * y
        h = rms_norm(x, norm2[l]) * (1.0 + sc2) + sh2
        gate, up = jnp.split(h @ w_gate_up[l], 2, axis=-1)
        x = x + g2 * ((jax.nn.silu(gate) * up) @ w_down[l])
    f_shift, f_scale = jnp.split((c_act @ final_mod_w + final_mod_b)[:, None, :], 2, axis=-1)
    return rms_norm(x, final_norm) * (1.0 + f_scale) + f_shift
```

```cpp
#include <hip/hip_runtime.h>
#include <hip/hip_cooperative_groups.h>
#include <cstdio>
#include <cstdint>
namespace cg = cooperative_groups;

#define LAS __attribute__((address_space(3)))
#define DI __device__ __forceinline__
typedef _Float16 h16;
typedef _Float16 half8 __attribute__((ext_vector_type(8)));
typedef _Float16 half4 __attribute__((ext_vector_type(4)));
typedef _Float16 half2v __attribute__((ext_vector_type(2)));
typedef short s16x4 __attribute__((ext_vector_type(4)));
typedef float f32x2 __attribute__((ext_vector_type(2)));
typedef float f32x4 __attribute__((ext_vector_type(4)));
typedef float f32x16 __attribute__((ext_vector_type(16)));

constexpr int D = 1024, NB = 16, SEQ = 2048, T = NB * SEQ, DEPTH = 4;
constexpr int DIN = 1952, DINP = 2048, FFN = 2816, NMOD = 6;
constexpr int KUP = 384, NUP = 1536;
constexpr int C_CQ = 0, C_CKV = 256, C_KR = 384, C_RQ = 416, C_RK = 544, C_RV = 672, C_RG = 928, C_UX = 1184, C_UG = 1568;
constexpr float EPS = 1e-6f;

constexpr size_t MiB = 1u << 20;
constexpr size_t WS_CTL = 0, CTL_BYTES = 4096;
constexpr size_t WS_MOD = 1 * MiB;
constexpr size_t WS_FMOD = 1 * MiB + 1536 * 1024 + 0;
constexpr size_t WS_CS = 3 * MiB;
constexpr size_t WS_LRUW = 7 * MiB;
constexpr size_t WS_WIN = 8 * MiB, WIN_STRIDE = 4 * MiB;
constexpr size_t WS_WUP = 24 * MiB, WUP_STRIDE = 2 * MiB;
constexpr size_t WS_WOUT = 32 * MiB, WOUT_STRIDE = 2 * MiB;
constexpr size_t WS_WGU = 40 * MiB, WGU_STRIDE = 11 * MiB;
constexpr size_t WS_WDN = 84 * MiB, WDN_STRIDE = 5632 * 1024;
constexpr size_t WS_H = 106 * MiB;
constexpr size_t WS_Z = 170 * MiB;
constexpr size_t WS_CQKV = 298 * MiB;
constexpr size_t WS_UP = 322 * MiB;
constexpr size_t WS_KR = 434 * MiB;
constexpr size_t WS_RQ = 418 * MiB;
constexpr size_t WS_RK = 426 * MiB;
constexpr size_t WS_HID = 170 * MiB;
constexpr size_t WS_XH = 436 * MiB;
constexpr size_t WS_XG2 = 346 * MiB;
constexpr size_t WS_RSS = 500 * MiB;
constexpr size_t WS_B1 = 502 * MiB;
constexpr size_t WS_B2 = 502 * MiB + 512 * 1024;
constexpr size_t WS_END = 504 * MiB;
static_assert(WS_HID + (size_t)T * FFN * 2 <= WS_XG2 && WS_XG2 + (size_t)T * D * 2 <= WS_RQ, "xg2 placement");
static_assert(WS_HID + (size_t)T * FFN * 2 <= WS_RQ, "hid overlay");

#ifndef PROBE_MODE
#define PROBE_MODE 0
#endif
#ifndef GEMM_SP2
#define GEMM_SP2 true
#endif
#ifndef GEMM_ALIGN
#define GEMM_ALIGN true
#endif
constexpr int LDS_BYTES = 147456;
constexpr int NTHREADS = 512;

struct Args { const float* in[26]; float* out; unsigned char* ws; int ph_lo, ph_hi; };

typedef const __attribute__((address_space(4))) Args* ArgsP;
DI ArgsP args_opaque() { ArgsP p = (ArgsP)__builtin_amdgcn_kernarg_segment_ptr(); asm volatile("" : "+s"(p)); return p; }
DI Args load_args(ArgsP p) { Args a;
#pragma unroll
    for (int i = 0; i < 26; ++i) a.in[i] = p->in[i];
    a.out = p->out; a.ws = p->ws; a.ph_lo = 0; a.ph_hi = 0; return a; }
DI int bid_opaque() { int b = blockIdx.x; asm volatile("" : "+s"(b)); return b; }
DI int gdim_opaque() { int b = gridDim.x; asm volatile("" : "+s"(b)); return b; }
DI int tid_opaque(int wid) { int t = wid * 64 + (int)__builtin_amdgcn_mbcnt_hi(~0u, __builtin_amdgcn_mbcnt_lo(~0u, 0u)); asm volatile("" : "+v"(t)); return t; }

namespace pg8 {
constexpr int BM = 256, BK = 64, HALF = 128, HTB = HALF * BK * 2, STAGE_BYTES = 8 * HTB, NXCD = 8, WGM = 8;
__host__ __device__ __forceinline__ int lds_byte(int r, int c) { const int st = (r >> 4) * 2 + (c >> 5), rr = r & 15, cc = c & 31, ob = rr * 64 + cc * 2; return st * 1024 + (ob ^ (((ob >> 9) & 1) << 5)); }
__host__ __device__ __forceinline__ void stage_rc(int b, int& R, int& C) { const int st = b / 1024, sb = b % 1024, swz = sb ^ (((sb >> 9) & 1) << 5); R = (st >> 1) * 16 + swz / 64; C = (st & 1) * 32 + (swz % 64) / 2; }
__host__ __device__ __forceinline__ int perm32(int rho) { const int n = rho >> 4, i = rho & 15; return 8 * (i >> 2) + 4 * n + (i & 3); }
struct Unit { int pm, pn, kb, nk; };
struct Gemm { const h16* A; const h16* Bt; int M, N, K; };
struct StaticOrder {
    int nM, nN, nwg, G, c, ntk, kmode;
    __device__ void init(int M, int N, int G_, int c_, int K = 0, int kmode_ = 0) { nM = M / BM; nN = N / BM; nwg = nM * nN; G = G_; c = c_; ntk = K / BK; kmode = kmode_; }
    __device__ bool next(int i, Unit& u) const {
        const long L = (long)i * G + c; if (L >= nwg) return false;
        int wgid = (int)L; { const int q = nwg / NXCD, r = nwg % NXCD, xcd = wgid % NXCD, off = wgid / NXCD; wgid = (xcd < r ? xcd * (q + 1) : r * (q + 1) + (xcd - r) * q) + off; }
        const int nig = WGM * nN, gid = wgid / nig, fm = gid * WGM, gsz = (nM - fm) < WGM ? (nM - fm) : WGM;
        u.pm = fm + ((wgid % nig) % gsz); u.pn = (wgid % nig) / gsz;
        if (kmode == 1) { if (u.pn <= 1) { u.kb = 0; u.nk = 4; } else if (u.pn == 2) { u.kb = 0; u.nk = 6; } else { u.kb = 4; u.nk = 2; } }
        else { u.kb = 0; u.nk = ntk; }
        return true;
    }
};
template <class Epi, bool ALIGN_EPI = false, bool SP2 = false>
__device__ __forceinline__ void gemm_phase(LAS unsigned char* lds, const Gemm g, const StaticOrder& S, const Epi& E, const int WID_) {
    const int tid = tid_opaque(WID_), wid = __builtin_amdgcn_readfirstlane(tid >> 6), lane = tid & 63, wr = wid >> 2, wc = wid & 3, fr = lane & 15, fq = lane >> 4;
    int K_ = g.K; asm volatile("" : "+s"(K_));
    const int K = K_, nt = K / BK;
    unsigned voffA[2], voffB[2];
#pragma unroll
    for (int i = 0; i < 2; ++i) { int R, C; stage_rc(tid * 16 + i * 8192, R, C); const int Rb = Epi::PERM ? ((R & ~31) + perm32(R & 31)) : R;
        voffA[i] = (unsigned)(R * K + C) * 2u; voffB[i] = (unsigned)(Rb * K + C) * 2u; }
    const size_t kstep = (size_t)(BK * 2);
    const size_t hstep = (size_t)HALF * K * 2;
    const size_t tstep = 2 * hstep;
    const unsigned ldsw = (unsigned)wid * 1024u;
    const int aoff = lds_byte(wr * 64 + fr, fq * 8), boff = lds_byte(wc * 32 + fr, fq * 8);
#define PG8_SA(b, h) (((b) * 2 + (h)) * HTB)
#define PG8_SB(b, h) ((4 + (b) * 2 + (h)) * HTB)
#define PG8_STAGE(bufoff, gbase, voff) do { _Pragma("unroll") for (int _i = 0; _i < 2; ++_i) \
        __builtin_amdgcn_global_load_lds((const unsigned*)((const char*)(gbase) + (voff)[_i]), (LAS unsigned*)(lds + (bufoff) + ldsw + _i * 8192), 16, 0, 0); } while (0)
#define PG8_LDA(dst, b, h) do { _Pragma("unroll") for (int m = 0; m < 4; ++m) _Pragma("unroll") for (int k = 0; k < 2; ++k) dst[m][k] = *(const LAS half8*)(lds + PG8_SA(b, h) + aoff + m * 2048 + k * 1024); } while (0)
#define PG8_LDB(dst, b, h) do { _Pragma("unroll") for (int n = 0; n < 2; ++n) _Pragma("unroll") for (int k = 0; k < 2; ++k) dst[n][k] = *(const LAS half8*)(lds + PG8_SB(b, h) + boff + n * 2048 + k * 1024); } while (0)
#define PG8_MMA(ai, bj, At, Bt) do { __builtin_amdgcn_s_setprio(1); _Pragma("unroll") for (int m = 0; m < 4; ++m) _Pragma("unroll") for (int n = 0; n < 2; ++n) _Pragma("unroll") for (int k = 0; k < 2; ++k) \
        acc[ai][bj][m][n] = __builtin_amdgcn_mfma_f32_16x16x32_f16(Bt[n][k], At[m][k], acc[ai][bj][m][n], 0, 0, 0); __builtin_amdgcn_s_setprio(0); } while (0)
#define PG8_WAIT_V(n) asm volatile("s_waitcnt vmcnt(" #n ")" ::: "memory")
#define PG8_WAIT_L(n) asm volatile("s_waitcnt lgkmcnt(" #n ")" ::: "memory")
#define PG8_BAR __builtin_amdgcn_s_barrier()
#define PG8_SCHED __builtin_amdgcn_sched_barrier(0)
    Unit cur, nxt; int ui = 0;
    if (!S.next(0, cur)) return;
    f32x4 acc[2][2][4][2];
#pragma unroll
    for (int a = 0; a < 2; ++a)
#pragma unroll
        for (int b = 0; b < 2; ++b)
#pragma unroll
            for (int m = 0; m < 4; ++m)
#pragma unroll
                for (int n = 0; n < 2; ++n) acc[a][b][m][n] = (f32x4){0.f, 0.f, 0.f, 0.f};
    half8 At[4][2], B0[2][2], B1[2][2];
    const char* cA = (const char*)g.A + (size_t)cur.pm * tstep + (size_t)cur.kb * kstep; const char* cB = (const char*)g.Bt + (size_t)cur.pn * tstep + (size_t)cur.kb * kstep;
    if constexpr (SP2) {
        PG8_STAGE(PG8_SB(0, 0), cB, voffB); PG8_STAGE(PG8_SB(0, 1), cB + hstep, voffB); PG8_STAGE(PG8_SA(0, 0), cA, voffA); PG8_STAGE(PG8_SA(0, 1), cA + hstep, voffA);
        if (wr == 1) PG8_BAR;
        PG8_WAIT_V(2); PG8_BAR;
        PG8_STAGE(PG8_SB(1, 0), cB + kstep, voffB); PG8_STAGE(PG8_SA(1, 0), cA + kstep, voffA); PG8_STAGE(PG8_SB(1, 1), cB + hstep + kstep, voffB);
        PG8_WAIT_V(6); PG8_BAR;
    } else {
    PG8_STAGE(PG8_SB(0, 0), cB, voffB); PG8_STAGE(PG8_SA(0, 0), cA, voffA); PG8_STAGE(PG8_SB(0, 1), cB + hstep, voffB); PG8_STAGE(PG8_SA(0, 1), cA + hstep, voffA);
    if (wr == 1) PG8_BAR;
    PG8_WAIT_V(4); PG8_BAR;
    PG8_STAGE(PG8_SB(1, 0), cB + kstep, voffB); PG8_STAGE(PG8_SA(1, 0), cA + kstep, voffA); PG8_STAGE(PG8_SB(1, 1), cB + hstep + kstep, voffB);
    PG8_WAIT_V(6); PG8_BAR;
    }
    for (;;) {
        const bool has_next = S.next(ui + 1, nxt);
        const char* nA = has_next ? (const char*)g.A + (size_t)nxt.pm * tstep + (size_t)nxt.kb * kstep : cA; const char* nB = has_next ? (const char*)g.Bt + (size_t)nxt.pn * tstep + (size_t)nxt.kb * kstep : cB;
        const int ntu = cur.nk;
        for (int t = 0; t < ntu; t += 2) {
            const bool last = (t == ntu - 2);
            const char* a1 = cA + (size_t)(t + 1) * kstep;
            const char* a2 = last ? nA : cA + (size_t)(t + 2) * kstep; const char* b2 = last ? nB : cB + (size_t)(t + 2) * kstep;
            const char* a3 = a2 + kstep; const char* b3 = b2 + kstep;
            if constexpr (SP2) {
            PG8_LDB(B0, 0, 0); PG8_LDB(B1, 0, 1); PG8_SCHED; PG8_LDA(At, 0, 0); PG8_STAGE(PG8_SA(1, 1), a1 + hstep, voffA);
            PG8_WAIT_V(8); PG8_WAIT_L(0); PG8_BAR; PG8_MMA(0, 0, At, B0); PG8_MMA(0, 1, At, B1); PG8_BAR; PG8_SCHED;
            PG8_LDA(At, 0, 1); PG8_STAGE(PG8_SB(0, 0), b2, voffB); PG8_STAGE(PG8_SB(0, 1), b2 + hstep, voffB); PG8_STAGE(PG8_SA(0, 0), a2, voffA);
            PG8_WAIT_V(8); PG8_WAIT_L(0); PG8_BAR; PG8_MMA(1, 0, At, B0); PG8_MMA(1, 1, At, B1); PG8_BAR; PG8_SCHED;
            PG8_LDB(B0, 1, 0); PG8_LDB(B1, 1, 1); PG8_SCHED; PG8_LDA(At, 1, 0); PG8_STAGE(PG8_SA(0, 1), a2 + hstep, voffA);
            PG8_WAIT_V(8); PG8_WAIT_L(0); PG8_BAR; PG8_MMA(0, 0, At, B0); PG8_MMA(0, 1, At, B1); PG8_BAR; PG8_SCHED;
            PG8_LDA(At, 1, 1); PG8_STAGE(PG8_SB(1, 0), b3, voffB); PG8_STAGE(PG8_SB(1, 1), b3 + hstep, voffB); PG8_STAGE(PG8_SA(1, 0), a3, voffA);
            PG8_WAIT_V(8); PG8_WAIT_L(0); PG8_BAR; PG8_MMA(1, 0, At, B0); PG8_MMA(1, 1, At, B1); PG8_BAR; PG8_SCHED;
            } else {
            PG8_LDB(B0, 0, 0); PG8_SCHED; PG8_LDA(At, 0, 0); PG8_STAGE(PG8_SA(1, 1), a1 + hstep, voffA);
            PG8_WAIT_L(8); PG8_BAR; PG8_WAIT_L(0); PG8_MMA(0, 0, At, B0); PG8_BAR; PG8_SCHED;
            PG8_LDB(B1, 0, 1); PG8_STAGE(PG8_SB(0, 0), b2, voffB);
            PG8_BAR; PG8_WAIT_L(0); PG8_MMA(0, 1, At, B1); PG8_BAR;
            PG8_LDA(At, 0, 1); PG8_STAGE(PG8_SA(0, 0), a2, voffA);
            PG8_BAR; PG8_WAIT_L(0); PG8_MMA(1, 0, At, B0); PG8_BAR; PG8_SCHED;
            PG8_STAGE(PG8_SB(0, 1), b2 + hstep, voffB);
            PG8_WAIT_V(6); PG8_BAR; PG8_MMA(1, 1, At, B1); PG8_BAR;
            PG8_LDB(B0, 1, 0); PG8_SCHED; PG8_LDA(At, 1, 0); PG8_STAGE(PG8_SA(0, 1), a2 + hstep, voffA);
            PG8_WAIT_L(8); PG8_BAR; PG8_WAIT_L(0); PG8_MMA(0, 0, At, B0); PG8_BAR; PG8_SCHED;
            PG8_LDB(B1, 1, 1); PG8_STAGE(PG8_SB(1, 0), b3, voffB);
            PG8_BAR; PG8_WAIT_L(0); PG8_MMA(0, 1, At, B1); PG8_BAR;
            PG8_LDA(At, 1, 1); PG8_STAGE(PG8_SA(1, 0), a3, voffA);
            PG8_BAR; PG8_WAIT_L(0); PG8_MMA(1, 0, At, B0); PG8_BAR; PG8_SCHED;
            PG8_STAGE(PG8_SB(1, 1), b3 + hstep, voffB);
            PG8_WAIT_V(6); PG8_BAR; PG8_MMA(1, 1, At, B1); PG8_BAR;
                    }
        }
        if constexpr (ALIGN_EPI) { if (wr == 0) PG8_BAR; }
        E(acc, cur, wr, wc, fr, fq);
        if (!has_next) break;
#pragma unroll
        for (int a = 0; a < 2; ++a)
#pragma unroll
            for (int b = 0; b < 2; ++b)
#pragma unroll
                for (int m = 0; m < 4; ++m)
#pragma unroll
                    for (int n = 0; n < 2; ++n) acc[a][b][m][n] = (f32x4){0.f, 0.f, 0.f, 0.f};
        cur = nxt; cA = nA; cB = nB; ++ui;
        if constexpr (ALIGN_EPI) { if (wr == 1) PG8_BAR; }
    }
    PG8_WAIT_V(0);
    if constexpr (!ALIGN_EPI) { if (wr == 0) PG8_BAR; }
    PG8_BAR;
#undef PG8_SA
#undef PG8_SB
#undef PG8_STAGE
#undef PG8_LDA
#undef PG8_LDB
#undef PG8_MMA
#undef PG8_WAIT_V
#undef PG8_WAIT_L
#undef PG8_BAR
#undef PG8_SCHED
}
}

DI half4 cvt4(f32x4 v) { half4 r; r[0] = (h16)v[0]; r[1] = (h16)v[1]; r[2] = (h16)v[2]; r[3] = (h16)v[3]; return r; }
DI float siluf(float v) { return v * __builtin_amdgcn_rcpf(1.0f + __expf(-v)); }

struct EpiF16 {
    static constexpr bool PERM = true;
    h16* O; int ldc;
    DI void operator()(const f32x4 (&acc)[2][2][4][2], const pg8::Unit& u, int wr, int wc, int fr, int fq) const {
        const int row0 = u.pm * 256 + wr * 64 + fr, col0 = u.pn * 256 + wc * 32 + 8 * fq;
#pragma unroll
        for (int ai = 0; ai < 2; ++ai)
#pragma unroll
            for (int m = 0; m < 4; ++m) { h16* rowp = O + (size_t)(row0 + ai * 128 + m * 16) * ldc + col0;
#pragma unroll
                for (int bj = 0; bj < 2; ++bj) { half8 w; const f32x4 v0 = acc[ai][bj][m][0], v1 = acc[ai][bj][m][1];
                    w[0] = (h16)v0[0]; w[1] = (h16)v0[1]; w[2] = (h16)v0[2]; w[3] = (h16)v0[3]; w[4] = (h16)v1[0]; w[5] = (h16)v1[1]; w[6] = (h16)v1[2]; w[7] = (h16)v1[3];
                    *(half8*)(rowp + bj * 128) = w; } }
    }
};
DI float shfl_xor_f(float v, int o, int lane) { return __builtin_bit_cast(float, __builtin_amdgcn_ds_bpermute((lane ^ o) << 2, __builtin_bit_cast(int, v))); }
struct EpiZ {
    static constexpr bool PERM = true;
    h16* O; int ldc; const float* rss; const float* bias; int ldb;
    DI void operator()(const f32x4 (&acc)[2][2][4][2], const pg8::Unit& u, int wr, int wc, int fr, int fq) const {
        const int row0 = u.pm * 256 + wr * 64 + fr, col0 = u.pn * 256 + wc * 32 + 8 * fq;
        const int b = (u.pm * 256) >> 11;
        f32x4 bv[2][2];
#pragma unroll
        for (int bj = 0; bj < 2; ++bj)
#pragma unroll
            for (int n = 0; n < 2; ++n) bv[bj][n] = *(const f32x4*)(bias + (size_t)b * ldb + col0 + bj * 128 + 4 * n);
#pragma unroll
        for (int ai = 0; ai < 2; ++ai)
#pragma unroll
            for (int m = 0; m < 4; ++m) { const int row = row0 + ai * 128 + m * 16; const float rstd = rsqrtf(rss[row] * (1.0f / D) + EPS);
                h16* rowp = O + (size_t)row * ldc + col0;
#pragma unroll
                for (int bj = 0; bj < 2; ++bj) { half8 w;
#pragma unroll
                    for (int n = 0; n < 2; ++n)
#pragma unroll
                        for (int j = 0; j < 4; ++j) w[4 * n + j] = (h16)(acc[ai][bj][m][n][j] * rstd + bv[bj][n][j]);
                    *(half8*)(rowp + bj * 128) = w; } }
    }
};
struct EpiSwiGLU {
    static constexpr bool PERM = true;
    h16* O; int ldc; const float* rss; const float* bias;
    DI void operator()(const f32x4 (&acc)[2][2][4][2], const pg8::Unit& u, int wr, int wc, int fr, int fq) const {
        const int row0 = u.pm * 256 + wr * 64 + fr, col0 = u.pn * 128 + wc * 32 + 8 * fq;
        const int b = (u.pm * 256) >> 11;
        f32x4 bg[2], bu[2];
#pragma unroll
        for (int n = 0; n < 2; ++n) { bg[n] = *(const f32x4*)(bias + (size_t)b * (2 * FFN) + col0 + 4 * n); bu[n] = *(const f32x4*)(bias + (size_t)b * (2 * FFN) + FFN + col0 + 4 * n); }
#pragma unroll
        for (int ai = 0; ai < 2; ++ai)
#pragma unroll
            for (int m = 0; m < 4; ++m) { const int row = row0 + ai * 128 + m * 16; const float rstd = rsqrtf(rss[row] * (1.0f / D) + EPS); half8 w;
#pragma unroll
                for (int n = 0; n < 2; ++n)
#pragma unroll
                    for (int j = 0; j < 4; ++j) { const float gt = acc[ai][0][m][n][j] * rstd + bg[n][j], up = acc[ai][1][m][n][j] * rstd + bu[n][j]; w[4 * n + j] = (h16)(siluf(gt) * up); }
                *(half8*)(O + (size_t)row * ldc + col0) = w; }
    }
};
struct EpiRes {
    static constexpr bool PERM = true;
    h16* x; const float* gate; int ldg; h16* xg; const float* gain; const float* sc; float* rss;
    DI void operator()(const f32x4 (&acc)[2][2][4][2], const pg8::Unit& u, int wr, int wc, int fr, int fq) const {
        const int row0 = u.pm * 256 + wr * 64 + fr, col0 = u.pn * 256 + wc * 32 + 8 * fq;
        const int b = (u.pm * 256) >> 11, lane = fr + 16 * fq;
        float ss[2][4];
#pragma unroll
        for (int ai = 0; ai < 2; ++ai)
#pragma unroll
            for (int m = 0; m < 4; ++m) ss[ai][m] = 0.f;
#pragma unroll
        for (int bj = 0; bj < 2; ++bj) {
            f32x4 gv[2], gm[2];
#pragma unroll
            for (int n = 0; n < 2; ++n) { gv[n] = *(const f32x4*)(gate + (size_t)b * ldg + col0 + bj * 128 + 4 * n);
                const f32x4 g4 = *(const f32x4*)(gain + col0 + bj * 128 + 4 * n), s4 = *(const f32x4*)(sc + (size_t)b * ldg + col0 + bj * 128 + 4 * n); gm[n] = g4 * (s4 + 1.0f); }
#pragma unroll
            for (int ai = 0; ai < 2; ++ai) {
                half8 xv[4];
#pragma unroll
                for (int m = 0; m < 4; ++m) xv[m] = *(const half8*)(x + (size_t)(row0 + ai * 128 + m * 16) * D + col0 + bj * 128);
                __builtin_amdgcn_sched_barrier(0);
#pragma unroll
                for (int m = 0; m < 4; ++m) { const int row = row0 + ai * 128 + m * 16; half8 w, wg; float s_ = 0.f;
#pragma unroll
                    for (int n = 0; n < 2; ++n)
#pragma unroll
                        for (int j = 0; j < 4; ++j) { const h16 hn = (h16)((float)xv[m][4 * n + j] + gv[n][j] * acc[ai][bj][m][n][j]); const float xr = (float)hn;
                            w[4 * n + j] = hn; s_ += xr * xr; wg[4 * n + j] = (h16)(xr * gm[n][j]); }
                    *(half8*)(x + (size_t)row * D + col0 + bj * 128) = w; ss[ai][m] += s_;
                    if (xg) *(half8*)(xg + (size_t)row * D + col0 + bj * 128) = wg; }
            }
        }
#pragma unroll
        for (int ai = 0; ai < 2; ++ai)
#pragma unroll
            for (int m = 0; m < 4; ++m) { float t = ss[ai][m]; t += shfl_xor_f(t, 16, lane); t += shfl_xor_f(t, 32, lane);
                if (fq == 0) unsafeAtomicAdd(rss + row0 + ai * 128 + m * 16, t); }
    }
};

struct EpiNull {
    static constexpr bool PERM = true;
    float* dummy;
    DI void operator()(const f32x4 (&acc)[2][2][4][2], const pg8::Unit& u, int wr, int wc, int fr, int fq) const {
        float t = 0.f;
#pragma unroll
        for (int ai = 0; ai < 2; ++ai)
#pragma unroll
            for (int bj = 0; bj < 2; ++bj)
#pragma unroll
                for (int m = 0; m < 4; ++m)
#pragma unroll
                    for (int n = 0; n < 2; ++n) t += acc[ai][bj][m][n][0] + acc[ai][bj][m][n][1] + acc[ai][bj][m][n][2] + acc[ai][bj][m][n][3];
        if (t == 1.2345678e33f) dummy[u.pm + wr + wc + fr + fq] = t;
    }
};
DI float wave_sum(float v, int lane) {
#pragma unroll
    for (int o = 32; o >= 1; o >>= 1) v += shfl_xor_f(v, o, lane);
    return v;
}
DI int crow(int reg, int hi) { return (reg & 3) + 8 * (reg >> 2) + 4 * hi; }

DI void xpose_tile(const float* __restrict__ src, int ld_src, int k0, int n0, int nvalid, h16* dst, int ldd, int dr0, int dk0, LAS float* scr, int lane, bool active) {
    if (active) {
#pragma unroll
        for (int hb = 0; hb < 2; ++hb) { float v[32];
#pragma unroll
            for (int i = 0; i < 32; ++i) { v[i] = 0.f; if (lane < nvalid) v[i] = src[(size_t)(k0 + 32 * hb + i) * ld_src + n0 + lane]; }
#pragma unroll
            for (int i = 0; i < 32; ++i) scr[(32 * hb + i) * 65 + lane] = v[i]; }
    }
    __syncthreads();
    if (active) {
        const int ic = lane & 7;
#pragma unroll
        for (int jj = 0; jj < 8; ++jj) { const int j = jj * 8 + (lane >> 3); half8 w;
#pragma unroll
            for (int e = 0; e < 8; ++e) w[e] = (h16)scr[(8 * ic + e) * 65 + j];
            *(half8*)(dst + (size_t)(dr0 + j) * ldd + dk0 + 8 * ic) = w; }
    }
    __syncthreads();
}

DI void p0_prologue(const Args& a, LAS unsigned char* lds, const int WID_) {
    const int tid = tid_opaque(WID_), lane = tid & 63, wave = tid >> 6;
    unsigned char* ws = a.ws;
    {
        LAS float* scr = (LAS float*)lds + wave * (64 * 65);
        constexpr int PER_LAYER = 512 + 144 + 256 + 1408 + 704 + 12;
        const int total = DEPTH * PER_LAYER, stride = gdim_opaque() * 8;
        for (int base = bid_opaque() * 8; base < total; base += stride) {
            const int id = base + wave; const bool active = id < total;
            const float* src = nullptr; int ld = 0, k0 = 0, n0 = 0, nvalid = 0, ldd = 0, dr0 = 0, dk0 = 0; h16* dst = nullptr;
            if (active) {
                const int l = id / PER_LAYER; int t = id - l * PER_LAYER;
                if (t < 512) { const int kt = t >> 5, nt = t & 31; src = a.in[6] + (size_t)l * D * DIN; ld = DIN; k0 = 64 * kt; n0 = 64 * nt; nvalid = DIN - n0; nvalid = nvalid < 0 ? 0 : (nvalid > 64 ? 64 : nvalid);
                    dst = (h16*)(ws + WS_WIN + l * WIN_STRIDE); ldd = D; dr0 = n0; dk0 = k0; }
                else if ((t -= 512) < 144) { const int kt = t / 24, nt = t - kt * 24; dst = (h16*)(ws + WS_WUP + l * WUP_STRIDE); ldd = KUP; dr0 = 64 * nt; dk0 = 64 * kt; nvalid = 0; src = a.in[8];
                    if (nt < 9) { if (kt < 4) { src = a.in[8] + (size_t)l * 256 * 576; ld = 576; k0 = 64 * kt; n0 = 64 * nt; nvalid = 64; } }
                    else if (nt < 21) { if (kt >= 4) { src = a.in[10] + (size_t)l * 128 * 768; ld = 768; k0 = 64 * (kt - 4); n0 = 64 * (nt - 9); nvalid = 64; } } }
                else if ((t -= 144) < 256) { const int kt = t >> 4, nt = t & 15; src = a.in[19] + (size_t)l * D * D; ld = D; k0 = 64 * kt; n0 = 64 * nt; nvalid = 64; dst = (h16*)(ws + WS_WOUT + l * WOUT_STRIDE); ldd = D; dr0 = n0; dk0 = k0; }
                else if ((t -= 256) < 1408) { const int kt = t / 88, nt = t - kt * 88; src = a.in[21] + (size_t)l * D * 2 * FFN; ld = 2 * FFN; k0 = 64 * kt; n0 = 64 * nt; nvalid = 64;
                    const int isup = n0 >= FFN, u0 = n0 - isup * FFN; dst = (h16*)(ws + WS_WGU + l * WGU_STRIDE); ldd = D; dr0 = 256 * (u0 >> 7) + 128 * isup + (u0 & 127); dk0 = k0; }
                else if ((t -= 1408) < 704) { const int kt = t >> 4, nt = t & 15; src = a.in[22] + (size_t)l * FFN * D; ld = D; k0 = 64 * kt; n0 = 64 * nt; nvalid = 64; dst = (h16*)(ws + WS_WDN + l * WDN_STRIDE); ldd = FFN; dr0 = n0; dk0 = k0; }
                else { t -= 704; const int gate = t / 6, g = t - gate * 6; src = a.in[gate ? 16 : 14] + (size_t)l * 6 * 4096 + g * 4096; ld = 64; k0 = 0; n0 = 0; nvalid = 64;
                    dst = (h16*)(ws + WS_LRUW) + (size_t)((l * 2 + gate) * 6 + g) * 4096; ldd = 64; dr0 = 0; dk0 = 0; }
            }
            xpose_tile(src, ld, k0, n0, nvalid, dst, ldd, dr0, dk0, scr, lane, active);
        }
    }
    __syncthreads();
    {
        LAS float* cact = (LAS float*)lds;
        LAS float* red = (LAS float*)(lds + 65536);
        const float* c = a.in[1];
        for (int idx = tid; idx < NB * D; idx += NTHREADS) { const int b = idx >> 10, k = idx & 1023; cact[k * 16 + b] = siluf(c[idx]); }
        __syncthreads();
        float* modv = (float*)(ws + WS_MOD); float* fmod = (float*)(ws + WS_FMOD);
        for (int item = bid_opaque(); item < 416; item += gdim_opaque()) {
            const float* W; const float* bias; float* outp; int ldw, n0;
            if (item < 384) { const int l = item / 96; n0 = (item - l * 96) * 64; W = a.in[3] + (size_t)l * D * 6144; ldw = 6144; bias = a.in[4] + l * 6144; outp = modv + (size_t)l * 16 * 6144; }
            else { n0 = (item - 384) * 64; W = a.in[24]; ldw = 2048; bias = a.in[25]; outp = fmod; }
            float acc[16];
#pragma unroll
            for (int b = 0; b < 16; ++b) acc[b] = 0.f;
            for (int kk0 = 0; kk0 < 128; kk0 += 16) { float wv[16];
#pragma unroll
                for (int u = 0; u < 16; ++u) wv[u] = W[(size_t)(wave * 128 + kk0 + u) * ldw + n0 + lane];
#pragma unroll
                for (int u = 0; u < 16; ++u) { const int k = wave * 128 + kk0 + u; const float w = wv[u];
#pragma unroll
                    for (int q = 0; q < 4; ++q) { const f32x4 cv = *(const LAS f32x4*)(cact + k * 16 + 4 * q);
                        acc[4 * q + 0] += cv[0] * w; acc[4 * q + 1] += cv[1] * w; acc[4 * q + 2] += cv[2] * w; acc[4 * q + 3] += cv[3] * w; } } }
#pragma unroll
            for (int b = 0; b < 16; ++b) red[(wave * 16 + b) * 64 + lane] = acc[b];
            __syncthreads();
            for (int o = tid; o < 1024; o += NTHREADS) { const int b = o >> 6, j = o & 63; float s = 0.f;
#pragma unroll
                for (int w = 0; w < 8; ++w) s += red[(w * 16 + b) * 64 + j];
                outp[(size_t)b * ldw + n0 + j] = s + bias[n0 + j]; }
            __syncthreads();
        }
    }
    {
        f32x4* r = (f32x4*)(ws + WS_RSS);
        for (int idx = bid_opaque() * NTHREADS + tid; idx < 9 * T / 4; idx += gdim_opaque() * NTHREADS) r[idx] = (f32x4){0.f, 0.f, 0.f, 0.f};
    }
    {
        f32x2* cs = (f32x2*)(ws + WS_CS); const int* pos = (const int*)a.in[2];
        for (int idx = bid_opaque() * NTHREADS + tid; idx < T * 16; idx += gdim_opaque() * NTHREADS) {
            const int tok = idx >> 4, j = idx & 15;
            const float inv = powf(10000.0f, -(float)j * 0.0625f);
            const float ang = (float)pos[tok] * inv;
            f32x2 r; r[0] = cosf(ang); r[1] = sinf(ang); cs[idx] = r;
        }
    }
}

DI void p0b_phase(const Args& a, LAS unsigned char* lds, const int WID_) {
    const int tid = tid_opaque(WID_), lane = tid & 63, wave = tid >> 6;
    unsigned char* ws = a.ws;
    const float* modv = (const float*)(ws + WS_MOD);
    {
        const float* x = a.in[0]; h16* XH = (h16*)(ws + WS_XH); h16* XG = (h16*)(ws + WS_H); float* rss = (float*)(ws + WS_RSS);
        const float* gain = a.in[5];
        for (int row = bid_opaque() * 8 + wave; row < T; row += gdim_opaque() * 8) {
            const int b = row >> 11; float ss = 0.f;
#pragma unroll
            for (int i = 0; i < 2; ++i) { const int col = i * 512 + lane * 8; half8 w, wg;
#pragma unroll
                for (int q = 0; q < 2; ++q) { const f32x4 v = *(const f32x4*)(x + (size_t)row * D + col + 4 * q), g = *(const f32x4*)(gain + col + 4 * q), sc = *(const f32x4*)(modv + (size_t)b * 6144 + 1 * D + col + 4 * q);
#pragma unroll
                    for (int j = 0; j < 4; ++j) { const h16 hn = (h16)v[j]; const float xr = (float)hn; w[4 * q + j] = hn; ss += xr * xr; wg[4 * q + j] = (h16)(xr * g[j] * (1.0f + sc[j])); } }
                *(half8*)(XH + (size_t)row * D + col) = w; *(half8*)(XG + (size_t)row * D + col) = wg; }
            ss = wave_sum(ss, lane);
            if (lane == 0) rss[row] = ss;
        }
    }
    __syncthreads();
    {
        LAS float* shl = (LAS float*)lds;
        LAS float* red = (LAS float*)(lds + 65536);
        for (int item = bid_opaque(); item < 4 * 119; item += gdim_opaque()) {
            const int l = item / 119, it = item - l * 119;
            const float* W; float* outp; int ldw, n0, nmax, ldo, shoff;
            if (it < 31) { n0 = it * 64; W = a.in[6] + (size_t)l * D * DIN; ldw = DIN; nmax = DIN; outp = (float*)(ws + WS_B1) + (size_t)l * 16 * DINP; ldo = DINP; shoff = 0; }
            else { n0 = (it - 31) * 64; W = a.in[21] + (size_t)l * D * 2 * FFN; ldw = 2 * FFN; nmax = 2 * FFN; outp = (float*)(ws + WS_B2) + (size_t)l * 16 * 2 * FFN; ldo = 2 * FFN; shoff = 3 * D; }
            const float* modl = modv + (size_t)l * 16 * 6144;
            for (int idx = tid; idx < NB * D; idx += NTHREADS) { const int b = idx >> 10, k = idx & 1023; shl[k * 16 + b] = modl[(size_t)b * 6144 + shoff + k]; }
            __syncthreads();
            const bool colok = (n0 + lane) < nmax;
            float acc[16];
#pragma unroll
            for (int b = 0; b < 16; ++b) acc[b] = 0.f;
            for (int kk0 = 0; kk0 < 128; kk0 += 16) { float wv[16];
#pragma unroll
                for (int u = 0; u < 16; ++u) wv[u] = colok ? W[(size_t)(wave * 128 + kk0 + u) * ldw + n0 + lane] : 0.f;
#pragma unroll
                for (int u = 0; u < 16; ++u) { const int k = wave * 128 + kk0 + u; const float w = wv[u];
#pragma unroll
                    for (int q = 0; q < 4; ++q) { const f32x4 cv = *(const LAS f32x4*)(shl + k * 16 + 4 * q);
                        acc[4 * q + 0] += cv[0] * w; acc[4 * q + 1] += cv[1] * w; acc[4 * q + 2] += cv[2] * w; acc[4 * q + 3] += cv[3] * w; } } }
#pragma unroll
            for (int b = 0; b < 16; ++b) red[(wave * 16 + b) * 64 + lane] = acc[b];
            __syncthreads();
            for (int o = tid; o < 1024; o += NTHREADS) { const int b = o >> 6, j = o & 63; float sm = 0.f;
#pragma unroll
                for (int w = 0; w < 8; ++w) sm += red[(w * 16 + b) * 64 + j];
                outp[(size_t)b * ldo + n0 + j] = sm; }
            __syncthreads();
        }
    }
}

DI void final_phase(const Args& a, const int WID_) {
    const int tid = tid_opaque(WID_), lane = tid & 63, wave = tid >> 6;
    unsigned char* ws = a.ws;
    const h16* XH = (const h16*)(ws + WS_XH); const float* rss = (const float*)(ws + WS_RSS) + (size_t)8 * T; const float* fmod = (const float*)(ws + WS_FMOD);
    const float* gain = a.in[23]; float* out = a.out;
    for (int row = bid_opaque() * 8 + wave; row < T; row += gdim_opaque() * 8) {
        const int b = row >> 11; const float rstd = rsqrtf(rss[row] * (1.0f / D) + EPS);
#pragma unroll
        for (int i = 0; i < 2; ++i) { const int col = i * 512 + lane * 8; const half8 v = *(const half8*)(XH + (size_t)row * D + col);
#pragma unroll
            for (int q = 0; q < 2; ++q) { const f32x4 g = *(const f32x4*)(gain + col + 4 * q), sc = *(const f32x4*)(fmod + (size_t)b * 2048 + D + col + 4 * q), sh = *(const f32x4*)(fmod + (size_t)b * 2048 + col + 4 * q); f32x4 y;
#pragma unroll
                for (int j = 0; j < 4; ++j) y[j] = (float)v[4 * q + j] * rstd * g[j] * (1.0f + sc[j]) + sh[j];
                *(f32x4*)(out + (size_t)row * D + col + 4 * q) = y; } }
    }
}

DI void prep_phase(const Args& a, int l, const int WID_) {
    const int tid = tid_opaque(WID_), lane = tid & 63, wave = tid >> 6;
    unsigned char* ws = a.ws;
    const h16* Z = (const h16*)(ws + WS_Z); h16* CQKV = (h16*)(ws + WS_CQKV); h16* KR = (h16*)(ws + WS_KR); h16* RQ = (h16*)(ws + WS_RQ); h16* RK = (h16*)(ws + WS_RK);
    const f32x2* cs = (const f32x2*)(ws + WS_CS);
    const float* qn = a.in[7] + l * 256; const float* kvn = a.in[9] + l * 128;
    const f32x4 qg = *(const f32x4*)(qn + 4 * lane); const f32x2 kg = *(const f32x2*)(kvn + 2 * lane);
    const int hh = lane >> 4, j = lane & 15;
    for (int tok = bid_opaque() * 8 + wave; tok < T; tok += gdim_opaque() * 8) {
        const h16* zr = Z + (size_t)tok * DINP; const int b = tok >> 11, s = tok & 2047;
        const half4 cq = *(const half4*)(zr + C_CQ + 4 * lane); const half2v ck = *(const half2v*)(zr + C_CKV + 2 * lane);
        const float kr1 = (float)zr[C_KR + j], kr2 = (float)zr[C_KR + 16 + j];
        const float q1 = (float)zr[C_RQ + 32 * hh + j], q2 = (float)zr[C_RQ + 32 * hh + 16 + j];
        const float k1 = (float)zr[C_RK + 32 * hh + j], k2 = (float)zr[C_RK + 32 * hh + 16 + j];
        const f32x2 c = cs[(size_t)tok * 16 + j];
        float f0 = (float)cq[0], f1 = (float)cq[1], f2 = (float)cq[2], f3 = (float)cq[3];
        float ssq = wave_sum(f0 * f0 + f1 * f1 + f2 * f2 + f3 * f3, lane);
        const float rq = rsqrtf(ssq * (1.0f / 256.0f) + EPS);
        half4 oq; oq[0] = (h16)(f0 * rq * qg[0]); oq[1] = (h16)(f1 * rq * qg[1]); oq[2] = (h16)(f2 * rq * qg[2]); oq[3] = (h16)(f3 * rq * qg[3]);
        *(half4*)(CQKV + (size_t)tok * KUP + 4 * lane) = oq;
        const float g0 = (float)ck[0], g1 = (float)ck[1];
        float ssk = wave_sum(g0 * g0 + g1 * g1, lane);
        const float rk = rsqrtf(ssk * (1.0f / 128.0f) + EPS);
        half2v ok; ok[0] = (h16)(g0 * rk * kg[0]); ok[1] = (h16)(g1 * rk * kg[1]);
        *(half2v*)(CQKV + (size_t)tok * KUP + 256 + 2 * lane) = ok;
        if (hh == 0) { h16* d0 = KR + (size_t)tok * 32; d0[j] = (h16)(kr1 * c[0] - kr2 * c[1]); d0[16 + j] = (h16)(kr1 * c[1] + kr2 * c[0]); }
        { h16* dq = RQ + ((size_t)(b * 4 + hh) * SEQ + s) * 32; dq[j] = (h16)(q1 * c[0] - q2 * c[1]); dq[16 + j] = (h16)(q1 * c[1] + q2 * c[0]);
          const float ks = 0.17677669529663687f;
          h16* dk = RK + ((size_t)(b * 4 + hh) * SEQ + s) * 32; dk[j] = (h16)((k1 * c[0] - k2 * c[1]) * ks); dk[16 + j] = (h16)((k1 * c[1] + k2 * c[0]) * ks); }
    }
}

template <bool RET>
DI void attn_unit(const Args& a, int l, int b, int h, int qb, LAS unsigned char* lds, const int WID_) {
    constexpr int DK = RET ? 32 : 96, KS = DK / 16, KSTR = RET ? 80 : 208, VSTR = 192, CPR = DK / 8;
    constexpr int TK = 128;
    constexpr int KBUF = TK * 208, VOFF = 2 * KBUF, VBUF = TK * VSTR, NKC = RET ? 1 : 3;
    const int tid = tid_opaque(WID_), lane = tid & 63, wave = WID_, l32 = lane & 31, hi = lane >> 5;
    unsigned char* ws = a.ws;
    const h16* UPb = (const h16*)(ws + WS_UP) + (size_t)b * SEQ * NUP;
    const h16* Qp = RET ? (const h16*)(ws + WS_RQ) + (size_t)(b * 4 + h) * SEQ * 32 : UPb + 96 * h;
    const h16* Kp = RET ? (const h16*)(ws + WS_RK) + (size_t)(b * 4 + h) * SEQ * 32 : UPb + 576 + 128 * h;
    const h16* KRp = (const h16*)(ws + WS_KR) + (size_t)b * SEQ * 32;
    const h16* Vp = RET ? (const h16*)(ws + WS_Z) + (size_t)b * SEQ * DINP + C_RV + 64 * h : UPb + 576 + 128 * h + 64;
    constexpr int vld = RET ? DINP : NUP, qld = RET ? 32 : NUP, kld = RET ? 32 : NUP;
    constexpr float QS = 0.10206207261596577f * 1.4426950408889634f;
    const int qrow = 256 * qb + 32 * wave + l32;
    const int qmax_w = 256 * qb + 32 * wave + 31, qmin_w = 256 * qb + 32 * wave;
    half8 qf[KS];
#pragma unroll
    for (int s = 0; s < KS; ++s) qf[s] = *(const half8*)(Qp + (size_t)qrow * qld + 16 * s + 8 * hi);
    if (!RET) {
        const f32x2* csp = (const f32x2*)(ws + WS_CS) + (size_t)(b * SEQ + qrow) * 16 + 8 * hi;
#pragma unroll
        for (int e = 0; e < 8; ++e) { const f32x2 c = csp[e]; const float x1 = (float)qf[KS - 2][e], x2 = (float)qf[KS - 1][e];
            qf[KS - 2][e] = (h16)(x1 * c[0] - x2 * c[1]); qf[KS - 1][e] = (h16)(x1 * c[1] + x2 * c[0]); }
    }
    f32x16 oacc[2];
#pragma unroll
    for (int i = 0; i < 16; ++i) { oacc[0][i] = 0.f; oacc[1][i] = 0.f; }
    float m_run = -INFINITY, l_run = 0.f;
    const float lg = RET ? log2f(1.0f - exp2f(-5.0f - (float)h)) : 0.f;
    float Bc[RET ? 2 : 1][RET ? 16 : 1];
    if (RET) {
#pragma unroll
        for (int mt = 0; mt < 2; ++mt)
#pragma unroll
            for (int i = 0; i < 16; ++i) Bc[mt][i] = __builtin_amdgcn_exp2f(-lg * (float)(32 * mt + crow(i, hi)));
    }
    int krow[NKC], kcc[NKC];
#pragma unroll
    for (int i = 0; i < NKC; ++i) { const int c = tid + 512 * i; krow[i] = c / CPR; kcc[i] = c - krow[i] * CPR; }
    const int vcc = tid & 7;
    const int nkt2 = 2 * (qb + 1);
    half8 kreg[NKC], vreg[2];
    auto gload = [&](int kt2) {
#pragma unroll
        for (int i = 0; i < NKC; ++i) kreg[i] = (RET || kcc[i] < 8) ? *(const half8*)(Kp + (size_t)(TK * kt2 + krow[i]) * kld + kcc[i] * 8) : *(const half8*)(KRp + (size_t)(TK * kt2 + krow[i]) * 32 + (kcc[i] - 8) * 8);
#pragma unroll
        for (int i = 0; i < 2; ++i) vreg[i] = *(const half8*)(Vp + (size_t)(TK * kt2 + (tid >> 3) + 64 * i) * vld + vcc * 8);
    };
    gload(0);
    const int li = lane & 15, q4 = li >> 2, p4 = li & 3, g1 = (lane >> 4) & 1;
    auto compute = [&](const int kt, LAS unsigned char* Kt, LAS unsigned char* Vt) {
        if (64 * kt <= qmax_w) {
            f32x16 sv[2];
#pragma unroll
            for (int i = 0; i < 16; ++i) { sv[0][i] = 0.f; sv[1][i] = 0.f; }
#pragma unroll
            for (int s = 0; s < KS; ++s) {
                const half8 kf0 = *(const LAS half8*)(Kt + l32 * KSTR + (16 * s + 8 * hi) * 2);
                const half8 kf1 = *(const LAS half8*)(Kt + (32 + l32) * KSTR + (16 * s + 8 * hi) * 2);
                sv[0] = __builtin_amdgcn_mfma_f32_32x32x16_f16(kf0, qf[s], sv[0], 0, 0, 0);
                sv[1] = __builtin_amdgcn_mfma_f32_32x32x16_f16(kf1, qf[s], sv[1], 0, 0, 0);
            }
            half8 vfr[2][2][2];
#pragma unroll
            for (int mt = 0; mt < 2; ++mt)
#pragma unroll
                for (int sp = 0; sp < 2; ++sp) {
                    const int krw = 32 * mt + 16 * sp + 4 * hi + q4;
#pragma unroll
                    for (int mtv = 0; mtv < 2; ++mtv) {
                        LAS unsigned char* ap = Vt + krw * VSTR + (32 * mtv + 16 * g1 + 4 * p4) * 2;
                        const s16x4 t0 = __builtin_amdgcn_ds_read_tr16_b64_v4i16((LAS s16x4*)ap);
                        const s16x4 t1 = __builtin_amdgcn_ds_read_tr16_b64_v4i16((LAS s16x4*)(ap + 8 * VSTR));
                        const half4 h0 = __builtin_bit_cast(half4, t0), h1 = __builtin_bit_cast(half4, t1);
                        half8 vf; vf[0] = h0[0]; vf[1] = h0[1]; vf[2] = h0[2]; vf[3] = h0[3]; vf[4] = h1[0]; vf[5] = h1[1]; vf[6] = h1[2]; vf[7] = h1[3];
                        vfr[mt][sp][mtv] = vf;
                    }
                }
            __builtin_amdgcn_sched_barrier(0);
            const bool need_mask = (64 * kt + 63 > qmin_w);
            half8 pf[2][2];
            if (!RET) {
                if (need_mask) {
#pragma unroll
                    for (int mt = 0; mt < 2; ++mt)
#pragma unroll
                        for (int i = 0; i < 16; ++i) { const int key = 64 * kt + 32 * mt + crow(i, hi); if (key > qrow) sv[mt][i] = -INFINITY; }
                }
                float mx = sv[0][0];
#pragma unroll
                for (int i = 1; i < 16; ++i) mx = fmaxf(mx, sv[0][i]);
#pragma unroll
                for (int i = 0; i < 16; ++i) mx = fmaxf(mx, sv[1][i]);
                mx = fmaxf(mx, shfl_xor_f(mx, 32, lane));
                constexpr float THR = 6.0f;
                const float pm = mx * QS;
                if (__builtin_amdgcn_ballot_w64((pm - m_run) > THR) != 0ull) {
                    asm volatile("" ::: "memory");
                    const float m_new = fmaxf(m_run, pm);
                    const float alpha = __builtin_amdgcn_exp2f(m_run - m_new);
                    m_run = m_new; l_run *= alpha;
#pragma unroll
                    for (int i = 0; i < 16; ++i) { oacc[0][i] *= alpha; oacc[1][i] *= alpha; }
                }
                f32x2 ps2 = {0.f, 0.f};
#pragma unroll
                for (int mt = 0; mt < 2; ++mt)
#pragma unroll
                    for (int i = 0; i < 16; i += 2) { const f32x2 t = (f32x2){sv[mt][i], sv[mt][i + 1]} * QS - m_run;
                        f32x2 pp; pp[0] = __builtin_amdgcn_exp2f(t[0]); pp[1] = __builtin_amdgcn_exp2f(t[1]); ps2 += pp;
                        pf[mt][i >> 3][i & 7] = (h16)pp[0]; pf[mt][i >> 3][(i & 7) + 1] = (h16)pp[1]; }
                l_run += ps2[0] + ps2[1];
            } else {
                const float Aq = __builtin_amdgcn_exp2f(lg * (float)(qrow - 64 * kt));
                if (need_mask) {
#pragma unroll
                    for (int mt = 0; mt < 2; ++mt)
#pragma unroll
                        for (int i = 0; i < 16; ++i) { const int key = 64 * kt + 32 * mt + crow(i, hi); if (key > qrow) sv[mt][i] = 0.f; }
                }
#pragma unroll
                for (int mt = 0; mt < 2; ++mt)
#pragma unroll
                    for (int i = 0; i < 16; ++i) pf[mt][i >> 3][i & 7] = (h16)(sv[mt][i] * (Aq * Bc[RET ? mt : 0][RET ? i : 0]));
            }
#pragma unroll
            for (int mt = 0; mt < 2; ++mt)
#pragma unroll
                for (int sp = 0; sp < 2; ++sp)
#pragma unroll
                    for (int mtv = 0; mtv < 2; ++mtv) oacc[mtv] = __builtin_amdgcn_mfma_f32_32x32x16_f16(vfr[mt][sp][mtv], pf[mt][sp], oacc[mtv], 0, 0, 0);
        }
    };
    for (int kt2 = 0; kt2 < nkt2; ++kt2) {
        const int buf = kt2 & 1;
        LAS unsigned char* Kt = lds + buf * KBUF; LAS unsigned char* Vt = lds + VOFF + buf * VBUF;
#pragma unroll
        for (int i = 0; i < NKC; ++i) *(LAS half8*)(Kt + krow[i] * KSTR + kcc[i] * 16) = kreg[i];
#pragma unroll
        for (int i = 0; i < 2; ++i) *(LAS half8*)(Vt + ((tid >> 3) + 64 * i) * VSTR + vcc * 16) = vreg[i];
        __syncthreads();
        gload(kt2 + 1 < nkt2 ? kt2 + 1 : kt2);
        compute(2 * kt2, Kt, Vt);
        compute(2 * kt2 + 1, Kt + 64 * KSTR, Vt + 64 * VSTR);
    }
    h16* Y = (h16*)(ws + WS_H) + (size_t)(b * SEQ + qrow) * D;
    if (!RET) {
        const float lt = l_run + shfl_xor_f(l_run, 32, lane); const float inv = 1.0f / lt;
#pragma unroll
        for (int mtv = 0; mtv < 2; ++mtv)
#pragma unroll
            for (int i4 = 0; i4 < 4; ++i4) { half4 w;
#pragma unroll
                for (int j = 0; j < 4; ++j) w[j] = (h16)(oacc[mtv][4 * i4 + j] * inv);
                *(half4*)(Y + h * 64 + 32 * mtv + 8 * i4 + 4 * hi) = w; }
    } else {
        float s1 = 0.f;
#pragma unroll
        for (int i = 0; i < 16; ++i) s1 += oacc[0][i] + oacc[1][i];
        s1 += shfl_xor_f(s1, 32, lane);
        const float mu = s1 * (1.0f / 64.0f);
        float s2 = 0.f;
#pragma unroll
        for (int i = 0; i < 16; ++i) { const float d0 = oacc[0][i] - mu, d1 = oacc[1][i] - mu; s2 += d0 * d0 + d1 * d1; }
        s2 += shfl_xor_f(s2, 32, lane);
        const float rstd = rsqrtf(s2 * (1.0f / 64.0f) + EPS);
        const float* gn = a.in[11] + l * 256 + h * 64;
        const h16* gp = (const h16*)(ws + WS_Z) + (size_t)(b * SEQ + qrow) * DINP + C_RG + h * 64;
#pragma unroll
        for (int mtv = 0; mtv < 2; ++mtv)
#pragma unroll
            for (int i4 = 0; i4 < 4; ++i4) { const int dv = 32 * mtv + 8 * i4 + 4 * hi;
                const half4 gg = *(const half4*)(gp + dv); const f32x4 gnv = *(const f32x4*)(gn + dv); half4 w;
#pragma unroll
                for (int j = 0; j < 4; ++j) w[j] = (h16)(siluf((float)gg[j]) * (oacc[mtv][4 * i4 + j] - mu) * rstd * gnv[j]);
                *(half4*)(Y + 384 + h * 64 + dv) = w; }
    }
}

DI float gelu_tanh(float x) { const float u = 0.7978845608028654f * (x + 0.044715f * x * x * x); const float t = 1.0f - 2.0f * __builtin_amdgcn_rcpf(1.0f + __expf(2.0f * u)); return 0.5f * x * (1.0f + t); }
DI float sigmoidf_(float v) { return __builtin_amdgcn_rcpf(1.0f + __expf(-v)); }
DI float neg_expm1(float x) { const float big = 1.0f - __expf(x); const float sm = -x * (1.0f + x * (0.5f + x * (0.16666667f + x * 0.041666668f))); return (x > -0.1f) ? sm : big; }
DI void lru_unit(const Args& a, int l, int b, int g, LAS unsigned char* lds, const int WID_) {
    const int tid = tid_opaque(WID_), lane = tid & 63, wave = WID_, l32 = lane & 31, hi = lane >> 5;
    unsigned char* ws = a.ws;
    const h16* Z = (const h16*)(ws + WS_Z) + (size_t)b * SEQ * DINP;
    h16* Y = (h16*)(ws + WS_H) + (size_t)b * SEQ * D + 640 + 64 * g + lane;
    const int ch = 64 * g + lane;
    const float cw0 = a.in[12][(l * 4 + 0) * 384 + ch], cw1 = a.in[12][(l * 4 + 1) * 384 + ch], cw2 = a.in[12][(l * 4 + 2) * 384 + ch], cw3 = a.in[12][(l * 4 + 3) * 384 + ch];
    const float cb = a.in[13][l * 384 + ch], ba = a.in[15][l * 384 + ch], bi = a.in[17][l * 384 + ch];
    const float lam = a.in[18][l * 384 + ch];
    const float sp8 = 8.0f * log1pf(expf(-lam));
    const h16* WA = (const h16*)(ws + WS_LRUW) + (size_t)((l * 2 + 0) * 6 + g) * 4096;
    const h16* WI = (const h16*)(ws + WS_LRUW) + (size_t)((l * 2 + 1) * 6 + g) * 4096;
    LAS unsigned char* reg = lds + wave * 16384;
    LAS float* Rb = (LAS float*)reg; LAS float* Ib = (LAS float*)(reg + 8192);
    LAS float* cA = (LAS float*)(lds + 131072); LAS float* cH = (LAS float*)(lds + 131072 + 2048);
    float h_round = 0.f;
    for (int rd = 0; rd < 8; ++rd) {
        const int t0 = rd * 256 + wave * 32;
        h16 gvh[32];
        {
            const h16* ug = Z + C_UG + ch;
#pragma unroll
            for (int t = 0; t < 32; ++t) gvh[t] = ug[(size_t)(t0 + t) * DINP];
        }
        half8 wfa[2][4], wfi[2][4];
#pragma unroll
        for (int nt = 0; nt < 2; ++nt)
#pragma unroll
            for (int s = 0; s < 4; ++s) { wfa[nt][s] = *(const half8*)(WA + (32 * nt + l32) * 64 + 16 * s + 8 * hi); wfi[nt][s] = *(const half8*)(WI + (32 * nt + l32) * 64 + 16 * s + 8 * hi); }
        float xc[32];
        {
            const h16* ux = Z + C_UX + ch;
            float xm3 = 0.f, xm2 = 0.f, xm1 = 0.f;
            if (t0 > 0) { xm3 = (float)ux[(size_t)(t0 - 3) * DINP]; xm2 = (float)ux[(size_t)(t0 - 2) * DINP]; xm1 = (float)ux[(size_t)(t0 - 1) * DINP]; }
            float xv[32];
#pragma unroll
            for (int t = 0; t < 32; ++t) xv[t] = (float)ux[(size_t)(t0 + t) * DINP];
#pragma unroll
            for (int t = 0; t < 32; ++t) { const float v = cb + cw0 * xm3 + cw1 * xm2 + cw2 * xm1 + cw3 * xv[t]; xc[t] = v; xm3 = xm2; xm2 = xm1; xm1 = xv[t];
                *(LAS h16*)(reg + t * 144 + lane * 2) = (h16)v; }
        }
        __syncthreads();
        {
            half8 xa[4];
#pragma unroll
            for (int s = 0; s < 4; ++s) xa[s] = *(const LAS half8*)(reg + l32 * 144 + (16 * s + 8 * hi) * 2);
            f32x16 ra[2], ia[2];
#pragma unroll
            for (int nt = 0; nt < 2; ++nt) {
#pragma unroll
                for (int i = 0; i < 16; ++i) { ra[nt][i] = 0.f; ia[nt][i] = 0.f; }
#pragma unroll
                for (int s = 0; s < 4; ++s) { ra[nt] = __builtin_amdgcn_mfma_f32_32x32x16_f16(xa[s], wfa[nt][s], ra[nt], 0, 0, 0); ia[nt] = __builtin_amdgcn_mfma_f32_32x32x16_f16(xa[s], wfi[nt][s], ia[nt], 0, 0, 0); }
            }
            __syncthreads();
#pragma unroll
            for (int nt = 0; nt < 2; ++nt)
#pragma unroll
                for (int i = 0; i < 16; ++i) { const int t = crow(i, hi); Rb[t * 64 + 32 * nt + l32] = ra[nt][i]; Ib[t * 64 + 32 * nt + l32] = ia[nt][i]; }
        }
        __syncthreads();
        float Ac = 1.f, hl = 0.f;
#pragma unroll
        for (int t = 0; t < 32; ++t) {
            const float ea = 1.0f + __expf(-(Rb[t * 64 + lane] + ba)), ei = 1.0f + __expf(-(Ib[t * 64 + lane] + bi));
            const float rc = __builtin_amdgcn_rcpf(ea * ei);
            const float r = ei * rc, ig = ea * rc;
            const float log_a = -sp8 * r;
            const float av = __expf(log_a);
            const float bv = __builtin_amdgcn_sqrtf(neg_expm1(2.0f * log_a)) * ig * xc[t];
            hl = av * hl + bv; Ac = Ac * av;
            Rb[t * 64 + lane] = Ac; Ib[t * 64 + lane] = hl;
        }
        cA[wave * 64 + lane] = Ac; cH[wave * 64 + lane] = hl;
        __syncthreads();
        float h_in = 0.f, hc = h_round;
#pragma unroll
        for (int w = 0; w < 8; ++w) { if (w == wave) h_in = hc; hc = cA[w * 64 + lane] * hc + cH[w * 64 + lane]; }
        h_round = hc;
        {
#pragma unroll
            for (int t = 0; t < 32; ++t) { const float hv = Ib[t * 64 + lane] + Rb[t * 64 + lane] * h_in; Y[(size_t)(t0 + t) * D] = (h16)(gelu_tanh((float)gvh[t]) * hv); }
        }
        __syncthreads();
    }
}

DI void mixer_phase(const Args& a, int lc, LAS unsigned char* lds, const int WID_) {
    const int l = lc & 3;
    unsigned* ctr = (unsigned*)(a.ws + WS_CTL) + 8 * (lc * 8);
    LAS unsigned* su = (LAS unsigned*)(lds + LDS_BYTES - 64);
    constexpr int PER_X = 12 + 8 * 20;
    const int x0 = (int)((unsigned)__builtin_amdgcn_s_getreg((3 << 11) | 20) & 7u);
    int xq = x0, tried = 0;
    for (;;) {
        if (tid_opaque(WID_) == 0) *su = atomicAdd(ctr + 8 * xq, 1u);
        __syncthreads();
        const int idx = (int)*su;
        __syncthreads();
        if (idx >= PER_X) { if (++tried >= 8) break; xq = (xq + 1) & 7; continue; }
        if (idx < 12) { const int u = xq + 8 * idx; lru_unit(a, l, u / 6, u % 6, lds, WID_); }
        else { const int v = idx - 12, qs = v / 20, w = v - qs * 20, qb = 7 - qs;
            if (w < 12) { const int bh = xq + 8 * w; attn_unit<false>(a, l, bh / 6, bh % 6, qb, lds, WID_); }
            else { const int r = xq + 8 * (w - 12); attn_unit<true>(a, l, r >> 2, r & 3, qb, lds, WID_); } }
        __syncthreads();
    }
}

DI void grid_bar(unsigned* ctr, unsigned target, const int WID_) {
    asm volatile("s_waitcnt vmcnt(0) lgkmcnt(0)" ::: "memory");
    __syncthreads();
    if (tid_opaque(WID_) == 0) {
        __builtin_amdgcn_fence(__ATOMIC_RELEASE, "agent");
        asm volatile("s_waitcnt vmcnt(0)" ::: "memory");
        (void)__hip_atomic_fetch_add(ctr, 1u, __ATOMIC_RELAXED, __HIP_MEMORY_SCOPE_AGENT);
        while (__hip_atomic_load(ctr, __ATOMIC_RELAXED, __HIP_MEMORY_SCOPE_AGENT) < target) __builtin_amdgcn_s_sleep(1);
        __builtin_amdgcn_fence(__ATOMIC_ACQUIRE, "agent");
        asm volatile("s_waitcnt vmcnt(0)" ::: "memory");
    }
    __syncthreads();
}

__global__ void __launch_bounds__(NTHREADS, 2) hymba_fwd(Args a_unused) {
    extern __shared__ __attribute__((aligned(16))) unsigned char lds_raw[];
    LAS unsigned char* lds = (LAS unsigned char*)lds_raw;
    cg::grid_group grid = cg::this_grid();
    const int WID_ = __builtin_amdgcn_readfirstlane((int)(threadIdx.x >> 6));
    int l = 0, nbar = 0;
#define PHASE_BEGIN(KIND) { const int nrep = (PROBE_MODE != 0 && PROBE_MODE == (KIND)) ? 2 : 1; for (int rep = 0; rep < nrep; ++rep) { const ArgsP ap = args_opaque(); const int BID = bid_opaque(), G = gdim_opaque(); (void)BID; (void)G; const Args a = load_args(ap); unsigned char* ws = a.ws; const float* modv = (const float*)(ws + WS_MOD); const float* modl = modv + (size_t)l * 16 * 6144; h16* XH = (h16*)(ws + WS_XH); float* RSS = (float*)(ws + WS_RSS); (void)RSS; \
    h16* H = (h16*)(ws + WS_H); h16* Z = (h16*)(ws + WS_Z); h16* HID = (h16*)(ws + WS_HID); (void)modl; (void)XH; (void)H; (void)Z; (void)HID;
#define PHASE_END_(LAST)   if (rep + 1 < nrep || !LAST) { if (gdim_opaque() == 0x7fffffff) grid.sync(); ++nbar; grid_bar((unsigned*)(args_opaque()->ws + WS_CTL) + 512, (unsigned)nbar * (unsigned)gdim_opaque(), WID_); } if (PROBE_MODE == 5) { ++nbar; grid_bar((unsigned*)(args_opaque()->ws + WS_CTL) + 512, (unsigned)nbar * (unsigned)gdim_opaque(), WID_); } } }
#define PHASE_END PHASE_END_(false)

    PHASE_BEGIN(1) p0_prologue(a, lds, WID_); PHASE_END
    PHASE_BEGIN(0) p0b_phase(a, lds, WID_); PHASE_END

    for (l = 0; l < DEPTH; ++l) {
        PHASE_BEGIN(2) { pg8::Gemm g{H, (const h16*)(ws + WS_WIN + l * WIN_STRIDE), T, DINP, D}; pg8::StaticOrder S; S.init(T, DINP, G, BID, D);
            EpiZ E{Z, DINP, RSS + (size_t)(2 * l) * T, (const float*)(ws + WS_B1) + (size_t)l * 16 * DINP, DINP}; pg8::gemm_phase<EpiZ, GEMM_ALIGN, GEMM_SP2>(lds, g, S, E, WID_); } PHASE_END
        PHASE_BEGIN(2) prep_phase(a, l, WID_); PHASE_END
        PHASE_BEGIN(2) { pg8::Gemm g{(const h16*)(ws + WS_CQKV), (const h16*)(ws + WS_WUP + l * WUP_STRIDE), T, NUP, KUP}; pg8::StaticOrder S; S.init(T, NUP, G, BID, KUP, 1);
            EpiF16 E{(h16*)(ws + WS_UP), NUP}; pg8::gemm_phase<EpiF16, GEMM_ALIGN, GEMM_SP2>(lds, g, S, E, WID_); } PHASE_END
        PHASE_BEGIN(3) mixer_phase(a, l + 4 * rep, lds, WID_); PHASE_END
#if PROBE_MODE == 9
        PHASE_BEGIN(0) { pg8::Gemm g{H, (const h16*)(ws + WS_WOUT + l * WOUT_STRIDE), T, D, D}; pg8::StaticOrder S; S.init(T, D, G, BID, D);
            EpiNull E{(float*)(ws + WS_CTL) + 768}; pg8::gemm_phase<EpiNull, GEMM_ALIGN, GEMM_SP2>(lds, g, S, E, WID_); } PHASE_END
#endif
        PHASE_BEGIN(0) { pg8::Gemm g{H, (const h16*)(ws + WS_WOUT + l * WOUT_STRIDE), T, D, D}; pg8::StaticOrder S; S.init(T, D, G, BID, D);
            EpiRes E{XH, modl + 2 * D, 6144, (h16*)(ws + WS_XG2), a.in[20] + l * D, modl + 4 * D, RSS + (size_t)(2 * l + 1) * T}; pg8::gemm_phase<EpiRes, GEMM_ALIGN, GEMM_SP2>(lds, g, S, E, WID_); } PHASE_END
        PHASE_BEGIN(4) { pg8::Gemm g{(const h16*)(ws + WS_XG2), (const h16*)(ws + WS_WGU + l * WGU_STRIDE), T, 2 * FFN, D}; pg8::StaticOrder S; S.init(T, 2 * FFN, G, BID, D);
            EpiSwiGLU E{HID, FFN, RSS + (size_t)(2 * l + 1) * T, (const float*)(ws + WS_B2) + (size_t)l * 16 * 2 * FFN}; pg8::gemm_phase<EpiSwiGLU, GEMM_ALIGN, GEMM_SP2>(lds, g, S, E, WID_); } PHASE_END
#if PROBE_MODE == 10
        PHASE_BEGIN(0) { pg8::Gemm g{HID, (const h16*)(ws + WS_WDN + l * WDN_STRIDE), T, D, FFN}; pg8::StaticOrder S; S.init(T, D, G, BID, FFN);
            EpiNull E{(float*)(ws + WS_CTL) + 768}; pg8::gemm_phase<EpiNull, GEMM_ALIGN, GEMM_SP2>(lds, g, S, E, WID_); } PHASE_END
#endif
        PHASE_BEGIN(0) { pg8::Gemm g{HID, (const h16*)(ws + WS_WDN + l * WDN_STRIDE), T, D, FFN}; pg8::StaticOrder S; S.init(T, D, G, BID, FFN);
            const int ln = (l + 1 < DEPTH) ? l + 1 : l;
            EpiRes E{XH, modl + 5 * D, 6144, (l + 1 < DEPTH) ? H : (h16*)nullptr, a.in[5] + ln * D, modv + (size_t)ln * 16 * 6144 + 1 * D, RSS + (size_t)(2 * l + 2) * T}; pg8::gemm_phase<EpiRes, GEMM_ALIGN, GEMM_SP2>(lds, g, S, E, WID_); } PHASE_END
    }
    PHASE_BEGIN(0) final_phase(a, WID_); PHASE_END_(true)
#undef PHASE_BEGIN
#undef PHASE_END
#undef PHASE_END_
}

extern "C" void kernel_launch(void* const* d_in, const int* in_sizes, int n_in, void* d_out, int out_size, void* d_ws, size_t ws_size, hipStream_t stream) {
    static int grid = 0;
    if (grid == 0) {
        if (n_in != 26 || out_size != T * D || ws_size < WS_END) { fprintf(stderr, "kernel_launch: unexpected shapes (n_in %d out %d ws %zu)\n", n_in, out_size, ws_size); grid = -1; return; }
        int dev = 0, cus = 0, per_cu = 0;
        hipGetDevice(&dev); hipDeviceGetAttribute(&cus, hipDeviceAttributeMultiprocessorCount, dev);
        if (hipFuncSetAttribute((const void*)hymba_fwd, hipFuncAttributeMaxDynamicSharedMemorySize, LDS_BYTES) != hipSuccess) { fprintf(stderr, "kernel_launch: hipFuncSetAttribute failed\n"); grid = -1; return; }
        if (hipOccupancyMaxActiveBlocksPerMultiprocessor(&per_cu, (const void*)hymba_fwd, NTHREADS, LDS_BYTES) != hipSuccess || per_cu < 1) { fprintf(stderr, "kernel_launch: occupancy query gave %d\n", per_cu); per_cu = 1; }
        (void)hipGetLastError();
        grid = cus * 1;
    }
    if (grid < 0) return;
    hipMemsetAsync((char*)d_ws + WS_CTL, 0, CTL_BYTES, stream);
    Args a{};
    for (int i = 0; i < 26; ++i) a.in[i] = (const float*)d_in[i];
    a.out = (float*)d_out; a.ws = (unsigned char*)d_ws; a.ph_lo = 0; a.ph_hi = 1 << 20;
    void* kargs[] = {&a};
    hipError_t e = hipLaunchCooperativeKernel((const void*)hymba_fwd, dim3(grid), dim3(NTHREADS), kargs, LDS_BYTES, stream);
    if (e != hipSuccess) fprintf(stderr, "kernel_launch: cooperative launch failed: %s (grid %d)\n", hipGetErrorString(e), grid);
}
```

```cpp
#include <hip/hip_runtime.h>
#include <hip/hip_cooperative_groups.h>
#include <cstdio>
#include <cstdint>
namespace cg = cooperative_groups;

#define LAS __attribute__((address_space(3)))
#define DI __device__ __forceinline__
typedef _Float16 h16;
typedef _Float16 half8 __attribute__((ext_vector_type(8)));
typedef _Float16 half4 __attribute__((ext_vector_type(4)));
typedef _Float16 half2v __attribute__((ext_vector_type(2)));
typedef short s16x4 __attribute__((ext_vector_type(4)));
typedef float f32x2 __attribute__((ext_vector_type(2)));
typedef float f32x4 __attribute__((ext_vector_type(4)));
typedef float f32x16 __attribute__((ext_vector_type(16)));

constexpr int D = 1024, NB = 16, SEQ = 2048, T = NB * SEQ, DEPTH = 4;
constexpr int DIN = 1952, DINP = 2048, FFN = 2816, NMOD = 6;
constexpr int KUP = 384, NUP = 1536;
constexpr int C_CQ = 0, C_CKV = 256, C_KR = 384, C_RQ = 416, C_RK = 544, C_RV = 672, C_RG = 928, C_UX = 1184, C_UG = 1568;
constexpr float EPS = 1e-6f;

constexpr size_t MiB = 1u << 20;
constexpr size_t WS_CTL = 0, CTL_BYTES = 4096;
constexpr size_t WS_MOD = 1 * MiB;
constexpr size_t WS_FMOD = 1 * MiB + 1536 * 1024 + 0;
constexpr size_t WS_CS = 3 * MiB;
constexpr size_t WS_LRUW = 7 * MiB;
constexpr size_t WS_WIN = 8 * MiB, WIN_STRIDE = 4 * MiB;
constexpr size_t WS_WUP = 24 * MiB, WUP_STRIDE = 2 * MiB;
constexpr size_t WS_WOUT = 32 * MiB, WOUT_STRIDE = 2 * MiB;
constexpr size_t WS_WGU = 40 * MiB, WGU_STRIDE = 11 * MiB;
constexpr size_t WS_WDN = 84 * MiB, WDN_STRIDE = 5632 * 1024;
constexpr size_t WS_H = 106 * MiB;
constexpr size_t WS_Z = 170 * MiB;
constexpr size_t WS_CQKV = 298 * MiB;
constexpr size_t WS_UP = 322 * MiB;
constexpr size_t WS_KR = 434 * MiB;
constexpr size_t WS_RQ = 418 * MiB;
constexpr size_t WS_RK = 426 * MiB;
constexpr size_t WS_HID = 170 * MiB;
constexpr size_t WS_XH = 436 * MiB;
constexpr size_t WS_XG2 = 346 * MiB;
constexpr size_t WS_RSS = 500 * MiB;
constexpr size_t WS_B1 = 502 * MiB;
constexpr size_t WS_B2 = 502 * MiB + 512 * 1024;
constexpr size_t WS_END = 504 * MiB;
static_assert(WS_HID + (size_t)T * FFN * 2 <= WS_XG2 && WS_XG2 + (size_t)T * D * 2 <= WS_RQ, "xg2 placement");
static_assert(WS_HID + (size_t)T * FFN * 2 <= WS_RQ, "hid overlay");

#ifndef PROBE_MODE
#define PROBE_MODE 0
#endif
#ifndef GEMM_SP2
#define GEMM_SP2 true
#endif
#ifndef GEMM_ALIGN
#define GEMM_ALIGN true
#endif
constexpr int LDS_BYTES = 147456;
constexpr int NTHREADS = 512;

struct Args { const float* in[26]; float* out; unsigned char* ws; int ph_lo, ph_hi; };

typedef const __attribute__((address_space(4))) Args* ArgsP;
DI ArgsP args_opaque() { ArgsP p = (ArgsP)__builtin_amdgcn_kernarg_segment_ptr(); asm volatile("" : "+s"(p)); return p; }
DI Args load_args(ArgsP p) { Args a;
#pragma unroll
    for (int i = 0; i < 26; ++i) a.in[i] = p->in[i];
    a.out = p->out; a.ws = p->ws; a.ph_lo = 0; a.ph_hi = 0; return a; }
DI int bid_opaque() { int b = blockIdx.x; asm volatile("" : "+s"(b)); return b; }
DI int gdim_opaque() { int b = gridDim.x; asm volatile("" : "+s"(b)); return b; }
DI int tid_opaque(int wid) { int t = wid * 64 + (int)__builtin_amdgcn_mbcnt_hi(~0u, __builtin_amdgcn_mbcnt_lo(~0u, 0u)); asm volatile("" : "+v"(t)); return t; }

namespace pg8 {
constexpr int BM = 256, BK = 64, HALF = 128, HTB = HALF * BK * 2, STAGE_BYTES = 8 * HTB, NXCD = 8, WGM = 8;
__host__ __device__ __forceinline__ int lds_byte(int r, int c) { const int st = (r >> 4) * 2 + (c >> 5), rr = r & 15, cc = c & 31, ob = rr * 64 + cc * 2; return st * 1024 + (ob ^ (((ob >> 9) & 1) << 5)); }
__host__ __device__ __forceinline__ void stage_rc(int b, int& R, int& C) { const int st = b / 1024, sb = b % 1024, swz = sb ^ (((sb >> 9) & 1) << 5); R = (st >> 1) * 16 + swz / 64; C = (st & 1) * 32 + (swz % 64) / 2; }
__host__ __device__ __forceinline__ int perm32(int rho) { const int n = rho >> 4, i = rho & 15; return 8 * (i >> 2) + 4 * n + (i & 3); }
struct Unit { int pm, pn, kb, nk; };
struct Gemm { const h16* A; const h16* Bt; int M, N, K; };
struct StaticOrder {
    int nM, nN, nwg, G, c, ntk, kmode;
    __device__ void init(int M, int N, int G_, int c_, int K = 0, int kmode_ = 0) { nM = M / BM; nN = N / BM; nwg = nM * nN; G = G_; c = c_; ntk = K / BK; kmode = kmode_; }
    __device__ bool next(int i, Unit& u) const {
        const long L = (long)i * G + c; if (L >= nwg) return false;
        int wgid = (int)L; { const int q = nwg / NXCD, r = nwg % NXCD, xcd = wgid % NXCD, off = wgid / NXCD; wgid = (xcd < r ? xcd * (q + 1) : r * (q + 1) + (xcd - r) * q) + off; }
        const int nig = WGM * nN, gid = wgid / nig, fm = gid * WGM, gsz = (nM - fm) < WGM ? (nM - fm) : WGM;
        u.pm = fm + ((wgid % nig) % gsz); u.pn = (wgid % nig) / gsz;
        if (kmode == 1) { if (u.pn <= 1) { u.kb = 0; u.nk = 4; } else if (u.pn == 2) { u.kb = 0; u.nk = 6; } else { u.kb = 4; u.nk = 2; } }
        else { u.kb = 0; u.nk = ntk; }
        return true;
    }
};
template <class Epi, bool ALIGN_EPI = false, bool SP2 = false>
__device__ __forceinline__ void gemm_phase(LAS unsigned char* lds, const Gemm g, const StaticOrder& S, const Epi& E, const int WID_) {
    const int tid = tid_opaque(WID_), wid = __builtin_amdgcn_readfirstlane(tid >> 6), lane = tid & 63, wr = wid >> 2, wc = wid & 3, fr = lane & 15, fq = lane >> 4;
    int K_ = g.K; asm volatile("" : "+s"(K_));
    const int K = K_, nt = K / BK;
    unsigned voffA[2], voffB[2];
#pragma unroll
    for (int i = 0; i < 2; ++i) { int R, C; stage_rc(tid * 16 + i * 8192, R, C); const int Rb = Epi::PERM ? ((R & ~31) + perm32(R & 31)) : R;
        voffA[i] = (unsigned)(R * K + C) * 2u; voffB[i] = (unsigned)(Rb * K + C) * 2u; }
    const size_t kstep = (size_t)(BK * 2);
    const size_t hstep = (size_t)HALF * K * 2;
    const size_t tstep = 2 * hstep;
    const unsigned ldsw = (unsigned)wid * 1024u;
    const int aoff = lds_byte(wr * 64 + fr, fq * 8), boff = lds_byte(wc * 32 + fr, fq * 8);
#define PG8_SA(b, h) (((b) * 2 + (h)) * HTB)
#define PG8_SB(b, h) ((4 + (b) * 2 + (h)) * HTB)
#define PG8_STAGE(bufoff, gbase, voff) do { _Pragma("unroll") for (int _i = 0; _i < 2; ++_i) \
        __builtin_amdgcn_global_load_lds((const unsigned*)((const char*)(gbase) + (voff)[_i]), (LAS unsigned*)(lds + (bufoff) + ldsw + _i * 8192), 16, 0, 0); } while (0)
#define PG8_LDA(dst, b, h) do { _Pragma("unroll") for (int m = 0; m < 4; ++m) _Pragma("unroll") for (int k = 0; k < 2; ++k) dst[m][k] = *(const LAS half8*)(lds + PG8_SA(b, h) + aoff + m * 2048 + k * 1024); } while (0)
#define PG8_LDB(dst, b, h) do { _Pragma("unroll") for (int n = 0; n < 2; ++n) _Pragma("unroll") for (int k = 0; k < 2; ++k) dst[n][k] = *(const LAS half8*)(lds + PG8_SB(b, h) + boff + n * 2048 + k * 1024); } while (0)
#define PG8_MMA(ai, bj, At, Bt) do { __builtin_amdgcn_s_setprio(1); _Pragma("unroll") for (int m = 0; m < 4; ++m) _Pragma("unroll") for (int n = 0; n < 2; ++n) _Pragma("unroll") for (int k = 0; k < 2; ++k) \
        acc[ai][bj][m][n] = __builtin_amdgcn_mfma_f32_16x16x32_f16(Bt[n][k], At[m][k], acc[ai][bj][m][n], 0, 0, 0); __builtin_amdgcn_s_setprio(0); } while (0)
#define PG8_WAIT_V(n) asm volatile("s_waitcnt vmcnt(" #n ")" ::: "memory")
#define PG8_WAIT_L(n) asm volatile("s_waitcnt lgkmcnt(" #n ")" ::: "memory")
#define PG8_BAR __builtin_amdgcn_s_barrier()
#define PG8_SCHED __builtin_amdgcn_sched_barrier(0)
    Unit cur, nxt; int ui = 0;
    if (!S.next(0, cur)) return;
    f32x4 acc[2][2][4][2];
#pragma unroll
    for (int a = 0; a < 2; ++a)
#pragma unroll
        for (int b = 0; b < 2; ++b)
#pragma unroll
            for (int m = 0; m < 4; ++m)
#pragma unroll
                for (int n = 0; n < 2; ++n) acc[a][b][m][n] = (f32x4){0.f, 0.f, 0.f, 0.f};
    half8 At[4][2], B0[2][2], B1[2][2];
    const char* cA = (const char*)g.A + (size_t)cur.pm * tstep + (size_t)cur.kb * kstep; const char* cB = (const char*)g.Bt + (size_t)cur.pn * tstep + (size_t)cur.kb * kstep;
    if constexpr (SP2) {
        PG8_STAGE(PG8_SB(0, 0), cB, voffB); PG8_STAGE(PG8_SB(0, 1), cB + hstep, voffB); PG8_STAGE(PG8_SA(0, 0), cA, voffA); PG8_STAGE(PG8_SA(0, 1), cA + hstep, voffA);
        if (wr == 1) PG8_BAR;
        PG8_WAIT_V(2); PG8_BAR;
        PG8_STAGE(PG8_SB(1, 0), cB + kstep, voffB); PG8_STAGE(PG8_SA(1, 0), cA + kstep, voffA); PG8_STAGE(PG8_SB(1, 1), cB + hstep + kstep, voffB);
        PG8_WAIT_V(6); PG8_BAR;
    } else {
    PG8_STAGE(PG8_SB(0, 0), cB, voffB); PG8_STAGE(PG8_SA(0, 0), cA, voffA); PG8_STAGE(PG8_SB(0, 1), cB + hstep, voffB); PG8_STAGE(PG8_SA(0, 1), cA + hstep, voffA);
    if (wr == 1) PG8_BAR;
    PG8_WAIT_V(4); PG8_BAR;
    PG8_STAGE(PG8_SB(1, 0), cB + kstep, voffB); PG8_STAGE(PG8_SA(1, 0), cA + kstep, voffA); PG8_STAGE(PG8_SB(1, 1), cB + hstep + kstep, voffB);
    PG8_WAIT_V(6); PG8_BAR;
    }
    for (;;) {
        const bool has_next = S.next(ui + 1, nxt);
        const char* nA = has_next ? (const char*)g.A + (size_t)nxt.pm * tstep + (size_t)nxt.kb * kstep : cA; const char* nB = has_next ? (const char*)g.Bt + (size_t)nxt.pn * tstep + (size_t)nxt.kb * kstep : cB;
        const int ntu = cur.nk;
        for (int t = 0; t < ntu; t += 2) {
            const bool last = (t == ntu - 2);
            const char* a1 = cA + (size_t)(t + 1) * kstep;
            const char* a2 = last ? nA : cA + (size_t)(t + 2) * kstep; const char* b2 = last ? nB : cB + (size_t)(t + 2) * kstep;
            const char* a3 = a2 + kstep; const char* b3 = b2 + kstep;
            if constexpr (SP2) {
            PG8_LDB(B0, 0, 0); PG8_LDB(B1, 0, 1); PG8_SCHED; PG8_LDA(At, 0, 0); PG8_STAGE(PG8_SA(1, 1), a1 + hstep, voffA);
            PG8_WAIT_V(8); PG8_WAIT_L(0); PG8_BAR; PG8_MMA(0, 0, At, B0); PG8_MMA(0, 1, At, B1); PG8_BAR; PG8_SCHED;
            PG8_LDA(At, 0, 1); PG8_STAGE(PG8_SB(0, 0), b2, voffB); PG8_STAGE(PG8_SB(0, 1), b2 + hstep, voffB); PG8_STAGE(PG8_SA(0, 0), a2, voffA);
            PG8_WAIT_V(8); PG8_WAIT_L(0); PG8_BAR; PG8_MMA(1, 0, At, B0); PG8_MMA(1, 1, At, B1); PG8_BAR; PG8_SCHED;
            PG8_LDB(B0, 1, 0); PG8_LDB(B1, 1, 1); PG8_SCHED; PG8_LDA(At, 1, 0); PG8_STAGE(PG8_SA(0, 1), a2 + hstep, voffA);
            PG8_WAIT_V(8); PG8_WAIT_L(0); PG8_BAR; PG8_MMA(0, 0, At, B0); PG8_MMA(0, 1, At, B1); PG8_BAR; PG8_SCHED;
            PG8_LDA(At, 1, 1); PG8_STAGE(PG8_SB(1, 0), b3, voffB); PG8_STAGE(PG8_SB(1, 1), b3 + hstep, voffB); PG8_STAGE(PG8_SA(1, 0), a3, voffA);
            PG8_WAIT_V(8); PG8_WAIT_L(0); PG8_BAR; PG8_MMA(1, 0, At, B0); PG8_MMA(1, 1, At, B1); PG8_BAR; PG8_SCHED;
            } else {
            PG8_LDB(B0, 0, 0); PG8_SCHED; PG8_LDA(At, 0, 0); PG8_STAGE(PG8_SA(1, 1), a1 + hstep, voffA);
            PG8_WAIT_L(8); PG8_BAR; PG8_WAIT_L(0); PG8_MMA(0, 0, At, B0); PG8_BAR; PG8_SCHED;
            PG8_LDB(B1, 0, 1); PG8_STAGE(PG8_SB(0, 0), b2, voffB);
            PG8_BAR; PG8_WAIT_L(0); PG8_MMA(0, 1, At, B1); PG8_BAR;
            PG8_LDA(At, 0, 1); PG8_STAGE(PG8_SA(0, 0), a2, voffA);
            PG8_BAR; PG8_WAIT_L(0); PG8_MMA(1, 0, At, B0); PG8_BAR; PG8_SCHED;
            PG8_STAGE(PG8_SB(0, 1), b2 + hstep, voffB);
            PG8_WAIT_V(6); PG8_BAR; PG8_MMA(1, 1, At, B1); PG8_BAR;
            PG8_LDB(B0, 1, 0); PG8_SCHED; PG8_LDA(At, 1, 0); PG8_STAGE(PG8_SA(0, 1), a2 + hstep, voffA);
            PG8_WAIT_L(8); PG8_BAR; PG8_WAIT_L(0); PG8_MMA(0, 0, At, B0); PG8_BAR; PG8_SCHED;
            PG8_LDB(B1, 1, 1); PG8_STAGE(PG8_SB(1, 0), b3, voffB);
            PG8_BAR; PG8_WAIT_L(0); PG8_MMA(0, 1, At, B1); PG8_BAR;
            PG8_LDA(At, 1, 1); PG8_STAGE(PG8_SA(1, 0), a3, voffA);
            PG8_BAR; PG8_WAIT_L(0); PG8_MMA(1, 0, At, B0); PG8_BAR; PG8_SCHED;
            PG8_STAGE(PG8_SB(1, 1), b3 + hstep, voffB);
            PG8_WAIT_V(6); PG8_BAR; PG8_MMA(1, 1, At, B1); PG8_BAR;
                    }
        }
        if constexpr (ALIGN_EPI) { if (wr == 0) PG8_BAR; }
        E(acc, cur, wr, wc, fr, fq);
        if (!has_next) break;
#pragma unroll
        for (int a = 0; a < 2; ++a)
#pragma unroll
            for (int b = 0; b < 2; ++b)
#pragma unroll
                for (int m = 0; m < 4; ++m)
#pragma unroll
                    for (int n = 0; n < 2; ++n) acc[a][b][m][n] = (f32x4){0.f, 0.f, 0.f, 0.f};
        cur = nxt; cA = nA; cB = nB; ++ui;
        if constexpr (ALIGN_EPI) { if (wr == 1) PG8_BAR; }
    }
    PG8_WAIT_V(0);
    if constexpr (!ALIGN_EPI) { if (wr == 0) PG8_BAR; }
    PG8_BAR;
#undef PG8_SA
#undef PG8_SB
#undef PG8_STAGE
#undef PG8_LDA
#undef PG8_LDB
#undef PG8_MMA
#undef PG8_WAIT_V
#undef PG8_WAIT_L
#undef PG8_BAR
#undef PG8_SCHED
}
}

DI half4 cvt4(f32x4 v) { half4 r; r[0] = (h16)v[0]; r[1] = (h16)v[1]; r[2] = (h16)v[2]; r[3] = (h16)v[3]; return r; }
DI float siluf(float v) { return v * __builtin_amdgcn_rcpf(1.0f + __expf(-v)); }

struct EpiF16 {
    static constexpr bool PERM = true;
    h16* O; int ldc;
    DI void operator()(const f32x4 (&acc)[2][2][4][2], const pg8::Unit& u, int wr, int wc, int fr, int fq) const {
        const int row0 = u.pm * 256 + wr * 64 + fr, col0 = u.pn * 256 + wc * 32 + 8 * fq;
#pragma unroll
        for (int ai = 0; ai < 2; ++ai)
#pragma unroll
            for (int m = 0; m < 4; ++m) { h16* rowp = O + (size_t)(row0 + ai * 128 + m * 16) * ldc + col0;
#pragma unroll
                for (int bj = 0; bj < 2; ++bj) { half8 w; const f32x4 v0 = acc[ai][bj][m][0], v1 = acc[ai][bj][m][1];
                    w[0] = (h16)v0[0]; w[1] = (h16)v0[1]; w[2] = (h16)v0[2]; w[3] = (h16)v0[3]; w[4] = (h16)v1[0]; w[5] = (h16)v1[1]; w[6] = (h16)v1[2]; w[7] = (h16)v1[3];
                    *(half8*)(rowp + bj * 128) = w; } }
    }
};
DI float shfl_xor_f(float v, int o, int lane) { return __builtin_bit_cast(float, __builtin_amdgcn_ds_bpermute((lane ^ o) << 2, __builtin_bit_cast(int, v))); }
struct EpiZ {
    static constexpr bool PERM = true;
    h16* O; int ldc; const float* rss; const float* bias; int ldb;
    DI void operator()(const f32x4 (&acc)[2][2][4][2], const pg8::Unit& u, int wr, int wc, int fr, int fq) const {
        const int row0 = u.pm * 256 + wr * 64 + fr, col0 = u.pn * 256 + wc * 32 + 8 * fq;
        const int b = (u.pm * 256) >> 11;
        f32x4 bv[2][2];
#pragma unroll
        for (int bj = 0; bj < 2; ++bj)
#pragma unroll
            for (int n = 0; n < 2; ++n) bv[bj][n] = *(const f32x4*)(bias + (size_t)b * ldb + col0 + bj * 128 + 4 * n);
#pragma unroll
        for (int ai = 0; ai < 2; ++ai)
#pragma unroll
            for (int m = 0; m < 4; ++m) { const int row = row0 + ai * 128 + m * 16; const float rstd = rsqrtf(rss[row] * (1.0f / D) + EPS);
                h16* rowp = O + (size_t)row * ldc + col0;
#pragma unroll
                for (int bj = 0; bj < 2; ++bj) { half8 w;
#pragma unroll
                    for (int n = 0; n < 2; ++n)
#pragma unroll
                        for (int j = 0; j < 4; ++j) w[4 * n + j] = (h16)(acc[ai][bj][m][n][j] * rstd + bv[bj][n][j]);
                    *(half8*)(rowp + bj * 128) = w; } }
    }
};
struct EpiSwiGLU {
    static constexpr bool PERM = true;
    h16* O; int ldc; const float* rss; const float* bias;
    DI void operator()(const f32x4 (&acc)[2][2][4][2], const pg8::Unit& u, int wr, int wc, int fr, int fq) const {
        const int row0 = u.pm * 256 + wr * 64 + fr, col0 = u.pn * 128 + wc * 32 + 8 * fq;
        const int b = (u.pm * 256) >> 11;
        f32x4 bg[2], bu[2];
#pragma unroll
        for (int n = 0; n < 2; ++n) { bg[n] = *(const f32x4*)(bias + (size_t)b * (2 * FFN) + col0 + 4 * n); bu[n] = *(const f32x4*)(bias + (size_t)b * (2 * FFN) + FFN + col0 + 4 * n); }
#pragma unroll
        for (int ai = 0; ai < 2; ++ai)
#pragma unroll
            for (int m = 0; m < 4; ++m) { const int row = row0 + ai * 128 + m * 16; const float rstd = rsqrtf(rss[row] * (1.0f / D) + EPS); half8 w;
#pragma unroll
                for (int n = 0; n < 2; ++n)
#pragma unroll
                    for (int j = 0; j < 4; ++j) { const float gt = acc[ai][0][m][n][j] * rstd + bg[n][j], up = acc[ai][1][m][n][j] * rstd + bu[n][j]; w[4 * n + j] = (h16)(siluf(gt) * up); }
                *(half8*)(O + (size_t)row * ldc + col0) = w; }
    }
};
struct EpiRes {
    static constexpr bool PERM = true;
    h16* x; const float* gate; int ldg; h16* xg; const float* gain; const float* sc; float* rss;
    DI void operator()(const f32x4 (&acc)[2][2][4][2], const pg8::Unit& u, int wr, int wc, int fr, int fq) const {
        const int row0 = u.pm * 256 + wr * 64 + fr, col0 = u.pn * 256 + wc * 32 + 8 * fq;
        const int b = (u.pm * 256) >> 11, lane = fr + 16 * fq;
        float ss[2][4];
#pragma unroll
        for (int ai = 0; ai < 2; ++ai)
#pragma unroll
            for (int m = 0; m < 4; ++m) ss[ai][m] = 0.f;
#pragma unroll
        for (int bj = 0; bj < 2; ++bj) {
            f32x4 gv[2], gm[2];
#pragma unroll
            for (int n = 0; n < 2; ++n) { gv[n] = *(const f32x4*)(gate + (size_t)b * ldg + col0 + bj * 128 + 4 * n);
                const f32x4 g4 = *(const f32x4*)(gain + col0 + bj * 128 + 4 * n), s4 = *(const f32x4*)(sc + (size_t)b * ldg + col0 + bj * 128 + 4 * n); gm[n] = g4 * (s4 + 1.0f); }
#pragma unroll
            for (int ai = 0; ai < 2; ++ai) {
                half8 xv[4];
#pragma unroll
                for (int m = 0; m < 4; ++m) xv[m] = *(const half8*)(x + (size_t)(row0 + ai * 128 + m * 16) * D + col0 + bj * 128);
                __builtin_amdgcn_sched_barrier(0);
#pragma unroll
                for (int m = 0; m < 4; ++m) { const int row = row0 + ai * 128 + m * 16; half8 w, wg; float s_ = 0.f;
#pragma unroll
                    for (int n = 0; n < 2; ++n)
#pragma unroll
                        for (int j = 0; j < 4; ++j) { const h16 hn = (h16)((float)xv[m][4 * n + j] + gv[n][j] * acc[ai][bj][m][n][j]); const float xr = (float)hn;
                            w[4 * n + j] = hn; s_ += xr * xr; wg[4 * n + j] = (h16)(xr * gm[n][j]); }
                    *(half8*)(x + (size_t)row * D + col0 + bj * 128) = w; ss[ai][m] += s_;
                    if (xg) *(half8*)(xg + (size_t)row * D + col0 + bj * 128) = wg; }
            }
        }
#pragma unroll
        for (int ai = 0; ai < 2; ++ai)
#pragma unroll
            for (int m = 0; m < 4; ++m) { float t = ss[ai][m]; t += shfl_xor_f(t, 16, lane); t += shfl_xor_f(t, 32, lane);
                if (fq == 0) unsafeAtomicAdd(rss + row0 + ai * 128 + m * 16, t); }
    }
};

struct EpiNull {
    static constexpr bool PERM = true;
    float* dummy;
    DI void operator()(const f32x4 (&acc)[2][2][4][2], const pg8::Unit& u, int wr, int wc, int fr, int fq) const {
        float t = 0.f;
#pragma unroll
        for (int ai = 0; ai < 2; ++ai)
#pragma unroll
            for (int bj = 0; bj < 2; ++bj)
#pragma unroll
                for (int m = 0; m < 4; ++m)
#pragma unroll
                    for (int n = 0; n < 2; ++n) t += acc[ai][bj][m][n][0] + acc[ai][bj][m][n][1] + acc[ai][bj][m][n][2] + acc[ai][bj][m][n][3];
        if (t == 1.2345678e33f) dummy[u.pm + wr + wc + fr + fq] = t;
    }
};
DI float wave_sum(float v, int lane) {
#pragma unroll
    for (int o = 32; o >= 1; o >>= 1) v += shfl_xor_f(v, o, lane);
    return v;
}
DI int crow(int reg, int hi) { return (reg & 3) + 8 * (reg >> 2) + 4 * hi; }

DI void xpose_tile(const float* __restrict__ src, int ld_src, int k0, int n0, int nvalid, h16* dst, int ldd, int dr0, int dk0, LAS float* scr, int lane, bool active) {
    if (active) {
#pragma unroll
        for (int hb = 0; hb < 2; ++hb) { float v[32];
#pragma unroll
            for (int i = 0; i < 32; ++i) { v[i] = 0.f; if (lane < nvalid) v[i] = src[(size_t)(k0 + 32 * hb + i) * ld_src + n0 + lane]; }
#pragma unroll
            for (int i = 0; i < 32; ++i) scr[(32 * hb + i) * 65 + lane] = v[i]; }
    }
    __syncthreads();
    if (active) {
        const int ic = lane & 7;
#pragma unroll
        for (int jj = 0; jj < 8; ++jj) { const int j = jj * 8 + (lane >> 3); half8 w;
#pragma unroll
            for (int e = 0; e < 8; ++e) w[e] = (h16)scr[(8 * ic + e) * 65 + j];
            *(half8*)(dst + (size_t)(dr0 + j) * ldd + dk0 + 8 * ic) = w; }
    }
    __syncthreads();
}

DI void p0_prologue(const Args& a, LAS unsigned char* lds, const int WID_) {
    const int tid = tid_opaque(WID_), lane = tid & 63, wave = tid >> 6;
    unsigned char* ws = a.ws;
    {
        LAS float* scr = (LAS float*)lds + wave * (64 * 65);
        constexpr int PER_LAYER = 512 + 144 + 256 + 1408 + 704 + 12;
        const int total = DEPTH * PER_LAYER, stride = gdim_opaque() * 8;
        for (int base = bid_opaque() * 8; base < total; base += stride) {
            const int id = base + wave; const bool active = id < total;
            const float* src = nullptr; int ld = 0, k0 = 0, n0 = 0, nvalid = 0, ldd = 0, dr0 = 0, dk0 = 0; h16* dst = nullptr;
            if (active) {
                const int l = id / PER_LAYER; int t = id - l * PER_LAYER;
                if (t < 512) { const int kt = t >> 5, nt = t & 31; src = a.in[6] + (size_t)l * D * DIN; ld = DIN; k0 = 64 * kt; n0 = 64 * nt; nvalid = DIN - n0; nvalid = nvalid < 0 ? 0 : (nvalid > 64 ? 64 : nvalid);
                    dst = (h16*)(ws + WS_WIN + l * WIN_STRIDE); ldd = D; dr0 = n0; dk0 = k0; }
                else if ((t -= 512) < 144) { const int kt = t / 24, nt = t - kt * 24; dst = (h16*)(ws + WS_WUP + l * WUP_STRIDE); ldd = KUP; dr0 = 64 * nt; dk0 = 64 * kt; nvalid = 0; src = a.in[8];
                    if (nt < 9) { if (kt < 4) { src = a.in[8] + (size_t)l * 256 * 576; ld = 576; k0 = 64 * kt; n0 = 64 * nt; nvalid = 64; } }
                    else if (nt < 21) { if (kt >= 4) { src = a.in[10] + (size_t)l * 128 * 768; ld = 768; k0 = 64 * (kt - 4); n0 = 64 * (nt - 9); nvalid = 64; } } }
                else if ((t -= 144) < 256) { const int kt = t >> 4, nt = t & 15; src = a.in[19] + (size_t)l * D * D; ld = D; k0 = 64 * kt; n0 = 64 * nt; nvalid = 64; dst = (h16*)(ws + WS_WOUT + l * WOUT_STRIDE); ldd = D; dr0 = n0; dk0 = k0; }
                else if ((t -= 256) < 1408) { const int kt = t / 88, nt = t - kt * 88; src = a.in[21] + (size_t)l * D * 2 * FFN; ld = 2 * FFN; k0 = 64 * kt; n0 = 64 * nt; nvalid = 64;
                    const int isup = n0 >= FFN, u0 = n0 - isup * FFN; dst = (h16*)(ws + WS_WGU + l * WGU_STRIDE); ldd = D; dr0 = 256 * (u0 >> 7) + 128 * isup + (u0 & 127); dk0 = k0; }
                else if ((t -= 1408) < 704) { const int kt = t >> 4, nt = t & 15; src = a.in[22] + (size_t)l * FFN * D; ld = D; k0 = 64 * kt; n0 = 64 * nt; nvalid = 64; dst = (h16*)(ws + WS_WDN + l * WDN_STRIDE); ldd = FFN; dr0 = n0; dk0 = k0; }
                else { t -= 704; const int gate = t / 6, g = t - gate * 6; src = a.in[gate ? 16 : 14] + (size_t)l * 6 * 4096 + g * 4096; ld = 64; k0 = 0; n0 = 0; nvalid = 64;
                    dst = (h16*)(ws + WS_LRUW) + (size_t)((l * 2 + gate) * 6 + g) * 4096; ldd = 64; dr0 = 0; dk0 = 0; }
            }
            xpose_tile(src, ld, k0, n0, nvalid, dst, ldd, dr0, dk0, scr, lane, active);
        }
    }
    __syncthreads();
    {
        LAS float* cact = (LAS float*)lds;
        LAS float* red = (LAS float*)(lds + 65536);
        const float* c = a.in[1];
        for (int idx = tid; idx < NB * D; idx += NTHREADS) { const int b = idx >> 10, k = idx & 1023; cact[k * 16 + b] = siluf(c[idx]); }
        __syncthreads();
        float* modv = (float*)(ws + WS_MOD); float* fmod = (float*)(ws + WS_FMOD);
        for (int item = bid_opaque(); item < 416; item += gdim_opaque()) {
            const float* W; const float* bias; float* outp; int ldw, n0;
            if (item < 384) { const int l = item / 96; n0 = (item - l * 96) * 64; W = a.in[3] + (size_t)l * D * 6144; ldw = 6144; bias = a.in[4] + l * 6144; outp = modv + (size_t)l * 16 * 6144; }
            else { n0 = (item - 384) * 64; W = a.in[24]; ldw = 2048; bias = a.in[25]; outp = fmod; }
            float acc[16];
#pragma unroll
            for (int b = 0; b < 16; ++b) acc[b] = 0.f;
            for (int kk0 = 0; kk0 < 128; kk0 += 16) { float wv[16];
#pragma unroll
                for (int u = 0; u < 16; ++u) wv[u] = W[(size_t)(wave * 128 + kk0 + u) * ldw + n0 + lane];
#pragma unroll
                for (int u = 0; u < 16; ++u) { const int k = wave * 128 + kk0 + u; const float w = wv[u];
#pragma unroll
                    for (int q = 0; q < 4; ++q) { const f32x4 cv = *(const LAS f32x4*)(cact + k * 16 + 4 * q);
                        acc[4 * q + 0] += cv[0] * w; acc[4 * q + 1] += cv[1] * w; acc[4 * q + 2] += cv[2] * w; acc[4 * q + 3] += cv[3] * w; } } }
#pragma unroll
            for (int b = 0; b < 16; ++b) red[(wave * 16 + b) * 64 + lane] = acc[b];
            __syncthreads();
            for (int o = tid; o < 1024; o += NTHREADS) { const int b = o >> 6, j = o & 63; float s = 0.f;
#pragma unroll
                for (int w = 0; w < 8; ++w) s += red[(w * 16 + b) * 64 + j];
                outp[(size_t)b * ldw + n0 + j] = s + bias[n0 + j]; }
            __syncthreads();
        }
    }
    {
        f32x4* r = (f32x4*)(ws + WS_RSS);
        for (int idx = bid_opaque() * NTHREADS + tid; idx < 9 * T / 4; idx += gdim_opaque() * NTHREADS) r[idx] = (f32x4){0.f, 0.f, 0.f, 0.f};
    }
    {
        f32x2* cs = (f32x2*)(ws + WS_CS); const int* pos = (const int*)a.in[2];
        for (int idx = bid_opaque() * NTHREADS + tid; idx < T * 16; idx += gdim_opaque() * NTHREADS) {
            const int tok = idx >> 4, j = idx & 15;
            const float inv = powf(10000.0f, -(float)j * 0.0625f);
            const float ang = (float)pos[tok] * inv;
            f32x2 r; r[0] = cosf(ang); r[1] = sinf(ang); cs[idx] = r;
        }
    }
}

DI void p0b_phase(const Args& a, LAS unsigned char* lds, const int WID_) {
    const int tid = tid_opaque(WID_), lane = tid & 63, wave = tid >> 6;
    unsigned char* ws = a.ws;
    const float* modv = (const float*)(ws + WS_MOD);
    {
        const float* x = a.in[0]; h16* XH = (h16*)(ws + WS_XH); h16* XG = (h16*)(ws + WS_H); float* rss = (float*)(ws + WS_RSS);
        const float* gain = a.in[5];
        for (int row = bid_opaque() * 8 + wave; row < T; row += gdim_opaque() * 8) {
            const int b = row >> 11; float ss = 0.f;
#pragma unroll
            for (int i = 0; i < 2; ++i) { const int col = i * 512 + lane * 8; half8 w, wg;
#pragma unroll
                for (int q = 0; q < 2; ++q) { const f32x4 v = *(const f32x4*)(x + (size_t)row * D + col + 4 * q), g = *(const f32x4*)(gain + col + 4 * q), sc = *(const f32x4*)(modv + (size_t)b * 6144 + 1 * D + col + 4 * q);
#pragma unroll
                    for (int j = 0; j < 4; ++j) { const h16 hn = (h16)v[j]; const float xr = (float)hn; w[4 * q + j] = hn; ss += xr * xr; wg[4 * q + j] = (h16)(xr * g[j] * (1.0f + sc[j])); } }
                *(half8*)(XH + (size_t)row * D + col) = w; *(half8*)(XG + (size_t)row * D + col) = wg; }
            ss = wave_sum(ss, lane);
            if (lane == 0) rss[row] = ss;
        }
    }
    __syncthreads();
    {
        LAS float* shl = (LAS float*)lds;
        LAS float* red = (LAS float*)(lds + 65536);
        for (int item = bid_opaque(); item < 4 * 119; item += gdim_opaque()) {
            const int l = item / 119, it = item - l * 119;
            const float* W; float* outp; int ldw, n0, nmax, ldo, shoff;
            if (it < 31) { n0 = it * 64; W = a.in[6] + (size_t)l * D * DIN; ldw = DIN; nmax = DIN; outp = (float*)(ws + WS_B1) + (size_t)l * 16 * DINP; ldo = DINP; shoff = 0; }
            else { n0 = (it - 31) * 64; W = a.in[21] + (size_t)l * D * 2 * FFN; ldw = 2 * FFN; nmax = 2 * FFN; outp = (float*)(ws + WS_B2) + (size_t)l * 16 * 2 * FFN; ldo = 2 * FFN; shoff = 3 * D; }
            const float* modl = modv + (size_t)l * 16 * 6144;
            for (int idx = tid; idx < NB * D; idx += NTHREADS) { const int b = idx >> 10, k = idx & 1023; shl[k * 16 + b] = modl[(size_t)b * 6144 + shoff + k]; }
            __syncthreads();
            const bool colok = (n0 + lane) < nmax;
            float acc[16];
#pragma unroll
            for (int b = 0; b < 16; ++b) acc[b] = 0.f;
            for (int kk0 = 0; kk0 < 128; kk0 += 16) { float wv[16];
#pragma unroll
                for (int u = 0; u < 16; ++u) wv[u] = colok ? W[(size_t)(wave * 128 + kk0 + u) * ldw + n0 + lane] : 0.f;
#pragma unroll
                for (int u = 0; u < 16; ++u) { const int k = wave * 128 + kk0 + u; const float w = wv[u];
#pragma unroll
                    for (int q = 0; q < 4; ++q) { const f32x4 cv = *(const LAS f32x4*)(shl + k * 16 + 4 * q);
                        acc[4 * q + 0] += cv[0] * w; acc[4 * q + 1] += cv[1] * w; acc[4 * q + 2] += cv[2] * w; acc[4 * q + 3] += cv[3] * w; } } }
#pragma unroll
            for (int b = 0; b < 16; ++b) red[(wave * 16 + b) * 64 + lane] = acc[b];
            __syncthreads();
            for (int o = tid; o < 1024; o += NTHREADS) { const int b = o >> 6, j = o & 63; float sm = 0.f;
#pragma unroll
                for (int w = 0; w < 8; ++w) sm += red[(w * 16 + b) * 64 + j];
                outp[(size_t)b * ldo + n0 + j] = sm; }
            __syncthreads();
        }
    }
}

DI void final_phase(const Args& a, const int WID_) {
    const int tid = tid_opaque(WID_), lane = tid & 63, wave = tid >> 6;
    unsigned char* ws = a.ws;
    const h16* XH = (const h16*)(ws + WS_XH); const float* rss = (const float*)(ws + WS_RSS) + (size_t)8 * T; const float* fmod = (const float*)(ws + WS_FMOD);
    const float* gain = a.in[23]; float* out = a.out;
    for (int row = bid_opaque() * 8 + wave; row < T; row += gdim_opaque() * 8) {
        const int b = row >> 11; const float rstd = rsqrtf(rss[row] * (1.0f / D) + EPS);
#pragma unroll
        for (int i = 0; i < 2; ++i) { const int col = i * 512 + lane * 8; const half8 v = *(const half8*)(XH + (size_t)row * D + col);
#pragma unroll
            for (int q = 0; q < 2; ++q) { const f32x4 g = *(const f32x4*)(gain + col + 4 * q), sc = *(const f32x4*)(fmod + (size_t)b * 2048 + D + col + 4 * q), sh = *(const f32x4*)(fmod + (size_t)b * 2048 + col + 4 * q); f32x4 y;
#pragma unroll
                for (int j = 0; j < 4; ++j) y[j] = (float)v[4 * q + j] * rstd * g[j] * (1.0f + sc[j]) + sh[j];
                *(f32x4*)(out + (size_t)row * D + col + 4 * q) = y; } }
    }
}

DI void prep_phase(const Args& a, int l, const int WID_) {
    const int tid = tid_opaque(WID_), lane = tid & 63, wave = tid >> 6;
    unsigned char* ws = a.ws;
    const h16* Z = (const h16*)(ws + WS_Z); h16* CQKV = (h16*)(ws + WS_CQKV); h16* KR = (h16*)(ws + WS_KR); h16* RQ = (h16*)(ws + WS_RQ); h16* RK = (h16*)(ws + WS_RK);
    const f32x2* cs = (const f32x2*)(ws + WS_CS);
    const float* qn = a.in[7] + l * 256; const float* kvn = a.in[9] + l * 128;
    const f32x4 qg = *(const f32x4*)(qn + 4 * lane); const f32x2 kg = *(const f32x2*)(kvn + 2 * lane);
    const int hh = lane >> 4, j = lane & 15;
    for (int tok = bid_opaque() * 8 + wave; tok < T; tok += gdim_opaque() * 8) {
        const h16* zr = Z + (size_t)tok * DINP; const int b = tok >> 11, s = tok & 2047;
        const half4 cq = *(const half4*)(zr + C_CQ + 4 * lane); const half2v ck = *(const half2v*)(zr + C_CKV + 2 * lane);
        const float kr1 = (float)zr[C_KR + j], kr2 = (float)zr[C_KR + 16 + j];
        const float q1 = (float)zr[C_RQ + 32 * hh + j], q2 = (float)zr[C_RQ + 32 * hh + 16 + j];
        const float k1 = (float)zr[C_RK + 32 * hh + j], k2 = (float)zr[C_RK + 32 * hh + 16 + j];
        const f32x2 c = cs[(size_t)tok * 16 + j];
        float f0 = (float)cq[0], f1 = (float)cq[1], f2 = (float)cq[2], f3 = (float)cq[3];
        float ssq = wave_sum(f0 * f0 + f1 * f1 + f2 * f2 + f3 * f3, lane);
        const float rq = rsqrtf(ssq * (1.0f / 256.0f) + EPS);
        half4 oq; oq[0] = (h16)(f0 * rq * qg[0]); oq[1] = (h16)(f1 * rq * qg[1]); oq[2] = (h16)(f2 * rq * qg[2]); oq[3] = (h16)(f3 * rq * qg[3]);
        *(half4*)(CQKV + (size_t)tok * KUP + 4 * lane) = oq;
        const float g0 = (float)ck[0], g1 = (float)ck[1];
        float ssk = wave_sum(g0 * g0 + g1 * g1, lane);
        const float rk = rsqrtf(ssk * (1.0f / 128.0f) + EPS);
        half2v ok; ok[0] = (h16)(g0 * rk * kg[0]); ok[1] = (h16)(g1 * rk * kg[1]);
        *(half2v*)(CQKV + (size_t)tok * KUP + 256 + 2 * lane) = ok;
        if (hh == 0) { h16* d0 = KR + (size_t)tok * 32; d0[j] = (h16)(kr1 * c[0] - kr2 * c[1]); d0[16 + j] = (h16)(kr1 * c[1] + kr2 * c[0]); }
        { h16* dq = RQ + ((size_t)(b * 4 + hh) * SEQ + s) * 32; dq[j] = (h16)(q1 * c[0] - q2 * c[1]); dq[16 + j] = (h16)(q1 * c[1] + q2 * c[0]);
          const float ks = 0.17677669529663687f;
          h16* dk = RK + ((size_t)(b * 4 + hh) * SEQ + s) * 32; dk[j] = (h16)((k1 * c[0] - k2 * c[1]) * ks); dk[16 + j] = (h16)((k1 * c[1] + k2 * c[0]) * ks); }
    }
}

template <bool RET>
DI void attn_unit(const Args& a, int l, int b, int h, int qb, LAS unsigned char* lds, const int WID_) {
    constexpr int DK = RET ? 32 : 96, KS = DK / 16, KSTR = RET ? 80 : 208, VSTR = 192, CPR = DK / 8;
    constexpr int TK = 128;
    constexpr int KBUF = TK * 208, VOFF = 2 * KBUF, VBUF = TK * VSTR, NKC = RET ? 1 : 3;
    const int tid = tid_opaque(WID_), lane = tid & 63, wave = WID_, l32 = lane & 31, hi = lane >> 5;
    unsigned char* ws = a.ws;
    const h16* UPb = (const h16*)(ws + WS_UP) + (size_t)b * SEQ * NUP;
    const h16* Qp = RET ? (const h16*)(ws + WS_RQ) + (size_t)(b * 4 + h) * SEQ * 32 : UPb + 96 * h;
    const h16* Kp = RET ? (const h16*)(ws + WS_RK) + (size_t)(b * 4 + h) * SEQ * 32 : UPb + 576 + 128 * h;
    const h16* KRp = (const h16*)(ws + WS_KR) + (size_t)b * SEQ * 32;
    const h16* Vp = RET ? (const h16*)(ws + WS_Z) + (size_t)b * SEQ * DINP + C_RV + 64 * h : UPb + 576 + 128 * h + 64;
    constexpr int vld = RET ? DINP : NUP, qld = RET ? 32 : NUP, kld = RET ? 32 : NUP;
    constexpr float QS = 0.10206207261596577f * 1.4426950408889634f;
    const int qrow = 256 * qb + 32 * wave + l32;
    const int qmax_w = 256 * qb + 32 * wave + 31, qmin_w = 256 * qb + 32 * wave;
    half8 qf[KS];
#pragma unroll
    for (int s = 0; s < KS; ++s) qf[s] = *(const half8*)(Qp + (size_t)qrow * qld + 16 * s + 8 * hi);
    if (!RET) {
        const f32x2* csp = (const f32x2*)(ws + WS_CS) + (size_t)(b * SEQ + qrow) * 16 + 8 * hi;
#pragma unroll
        for (int e = 0; e < 8; ++e) { const f32x2 c = csp[e]; const float x1 = (float)qf[KS - 2][e], x2 = (float)qf[KS - 1][e];
            qf[KS - 2][e] = (h16)(x1 * c[0] - x2 * c[1]); qf[KS - 1][e] = (h16)(x1 * c[1] + x2 * c[0]); }
    }
    f32x16 oacc[2];
#pragma unroll
    for (int i = 0; i < 16; ++i) { oacc[0][i] = 0.f; oacc[1][i] = 0.f; }
    float m_run = -INFINITY, l_run = 0.f;
    const float lg = RET ? log2f(1.0f - exp2f(-5.0f - (float)h)) : 0.f;
    float Bc[RET ? 2 : 1][RET ? 16 : 1];
    if (RET) {
#pragma unroll
        for (int mt = 0; mt < 2; ++mt)
#pragma unroll
            for (int i = 0; i < 16; ++i) Bc[mt][i] = __builtin_amdgcn_exp2f(-lg * (float)(32 * mt + crow(i, hi)));
    }
    int krow[NKC], kcc[NKC];
#pragma unroll
    for (int i = 0; i < NKC; ++i) { const int c = tid + 512 * i; krow[i] = c / CPR; kcc[i] = c - krow[i] * CPR; }
    const int vcc = tid & 7;
    const int nkt2 = 2 * (qb + 1);
    half8 kreg[NKC], vreg[2];
    auto gload = [&](int kt2) {
#pragma unroll
        for (int i = 0; i < NKC; ++i) kreg[i] = (RET || kcc[i] < 8) ? *(const half8*)(Kp + (size_t)(TK * kt2 + krow[i]) * kld + kcc[i] * 8) : *(const half8*)(KRp + (size_t)(TK * kt2 + krow[i]) * 32 + (kcc[i] - 8) * 8);
#pragma unroll
        for (int i = 0; i < 2; ++i) vreg[i] = *(const half8*)(Vp + (size_t)(TK * kt2 + (tid >> 3) + 64 * i) * vld + vcc * 8);
    };
    gload(0);
    const int li = lane & 15, q4 = li >> 2, p4 = li & 3, g1 = (lane >> 4) & 1;
    auto compute = [&](const int kt, LAS unsigned char* Kt, LAS unsigned char* Vt) {
        if (64 * kt <= qmax_w) {
            f32x16 sv[2];
#pragma unroll
            for (int i = 0; i < 16; ++i) { sv[0][i] = 0.f; sv[1][i] = 0.f; }
#pragma unroll
            for (int s = 0; s < KS; ++s) {
                const half8 kf0 = *(const LAS half8*)(Kt + l32 * KSTR + (16 * s + 8 * hi) * 2);
                const half8 kf1 = *(const LAS half8*)(Kt + (32 + l32) * KSTR + (16 * s + 8 * hi) * 2);
                sv[0] = __builtin_amdgcn_mfma_f32_32x32x16_f16(kf0, qf[s], sv[0], 0, 0, 0);
                sv[1] = __builtin_amdgcn_mfma_f32_32x32x16_f16(kf1, qf[s], sv[1], 0, 0, 0);
            }
            half8 vfr[2][2][2];
#pragma unroll
            for (int mt = 0; mt < 2; ++mt)
#pragma unroll
                for (int sp = 0; sp < 2; ++sp) {
                    const int krw = 32 * mt + 16 * sp + 4 * hi + q4;
#pragma unroll
                    for (int mtv = 0; mtv < 2; ++mtv) {
                        LAS unsigned char* ap = Vt + krw * VSTR + (32 * mtv + 16 * g1 + 4 * p4) * 2;
                        const s16x4 t0 = __builtin_amdgcn_ds_read_tr16_b64_v4i16((LAS s16x4*)ap);
                        const s16x4 t1 = __builtin_amdgcn_ds_read_tr16_b64_v4i16((LAS s16x4*)(ap + 8 * VSTR));
                        const half4 h0 = __builtin_bit_cast(half4, t0), h1 = __builtin_bit_cast(half4, t1);
                        half8 vf; vf[0] = h0[0]; vf[1] = h0[1]; vf[2] = h0[2]; vf[3] = h0[3]; vf[4] = h1[0]; vf[5] = h1[1]; vf[6] = h1[2]; vf[7] = h1[3];
                        vfr[mt][sp][mtv] = vf;
                    }
                }
            __builtin_amdgcn_sched_barrier(0);
            const bool need_mask = (64 * kt + 63 > qmin_w);
            half8 pf[2][2];
            if (!RET) {
                if (need_mask) {
#pragma unroll
                    for (int mt = 0; mt < 2; ++mt)
#pragma unroll
                        for (int i = 0; i < 16; ++i) { const int key = 64 * kt + 32 * mt + crow(i, hi); if (key > qrow) sv[mt][i] = -INFINITY; }
                }
                float mx = sv[0][0];
#pragma unroll
                for (int i = 1; i < 16; ++i) mx = fmaxf(mx, sv[0][i]);
#pragma unroll
                for (int i = 0; i < 16; ++i) mx = fmaxf(mx, sv[1][i]);
                mx = fmaxf(mx, shfl_xor_f(mx, 32, lane));
                constexpr float THR = 6.0f;
                const float pm = mx * QS;
                if (__builtin_amdgcn_ballot_w64((pm - m_run) > THR) != 0ull) {
                    asm volatile("" ::: "memory");
                    const float m_new = fmaxf(m_run, pm);
                    const float alpha = __builtin_amdgcn_exp2f(m_run - m_new);
                    m_run = m_new; l_run *= alpha;
#pragma unroll
                    for (int i = 0; i < 16; ++i) { oacc[0][i] *= alpha; oacc[1][i] *= alpha; }
                }
                f32x2 ps2 = {0.f, 0.f};
#pragma unroll
                for (int mt = 0; mt < 2; ++mt)
#pragma unroll
                    for (int i = 0; i < 16; i += 2) { const f32x2 t = (f32x2){sv[mt][i], sv[mt][i + 1]} * QS - m_run;
                        f32x2 pp; pp[0] = __builtin_amdgcn_exp2f(t[0]); pp[1] = __builtin_amdgcn_exp2f(t[1]); ps2 += pp;
                        pf[mt][i >> 3][i & 7] = (h16)pp[0]; pf[mt][i >> 3][(i & 7) + 1] = (h16)pp[1]; }
                l_run += ps2[0] + ps2[1];
            } else {
                const float Aq = __builtin_amdgcn_exp2f(lg * (float)(qrow - 64 * kt));
                if (need_mask) {
#pragma unroll
                    for (int mt = 0; mt < 2; ++mt)
#pragma unroll
                        for (int i = 0; i < 16; ++i) { const int key = 64 * kt + 32 * mt + crow(i, hi); if (key > qrow) sv[mt][i] = 0.f; }
                }
#pragma unroll
                for (int mt = 0; mt < 2; ++mt)
#pragma unroll
                    for (int i = 0; i < 16; ++i) pf[mt][i >> 3][i & 7] = (h16)(sv[mt][i] * (Aq * Bc[RET ? mt : 0][RET ? i : 0]));
            }
#pragma unroll
            for (int mt = 0; mt < 2; ++mt)
#pragma unroll
                for (int sp = 0; sp < 2; ++sp)
#pragma unroll
                    for (int mtv = 0; mtv < 2; ++mtv) oacc[mtv] = __builtin_amdgcn_mfma_f32_32x32x16_f16(vfr[mt][sp][mtv], pf[mt][sp], oacc[mtv], 0, 0, 0);
        }
    };
    for (int kt2 = 0; kt2 < nkt2; ++kt2) {
        const int buf = kt2 & 1;
        LAS unsigned char* Kt = lds + buf * KBUF; LAS unsigned char* Vt = lds + VOFF + buf * VBUF;
#pragma unroll
        for (int i = 0; i < NKC; ++i) *(LAS half8*)(Kt + krow[i] * KSTR + kcc[i] * 16) = kreg[i];
#pragma unroll
        for (int i = 0; i < 2; ++i) *(LAS half8*)(Vt + ((tid >> 3) + 64 * i) * VSTR + vcc * 16) = vreg[i];
        __syncthreads();
        gload(kt2 + 1 < nkt2 ? kt2 + 1 : kt2);
        compute(2 * kt2, Kt, Vt);
        compute(2 * kt2 + 1, Kt + 64 * KSTR, Vt + 64 * VSTR);
    }
    h16* Y = (h16*)(ws + WS_H) + (size_t)(b * SEQ + qrow) * D;
    if (!RET) {
        const float lt = l_run + shfl_xor_f(l_run, 32, lane); const float inv = 1.0f / lt;
#pragma unroll
        for (int mtv = 0; mtv < 2; ++mtv)
#pragma unroll
            for (int i4 = 0; i4 < 4; ++i4) { half4 w;
#pragma unroll
                for (int j = 0; j < 4; ++j) w[j] = (h16)(oacc[mtv][4 * i4 + j] * inv);
                *(half4*)(Y + h * 64 + 32 * mtv + 8 * i4 + 4 * hi) = w; }
    } else {
        float s1 = 0.f;
#pragma unroll
        for (int i = 0; i < 16; ++i) s1 += oacc[0][i] + oacc[1][i];
        s1 += shfl_xor_f(s1, 32, lane);
        const float mu = s1 * (1.0f / 64.0f);
        float s2 = 0.f;
#pragma unroll
        for (int i = 0; i < 16; ++i) { const float d0 = oacc[0][i] - mu, d1 = oacc[1][i] - mu; s2 += d0 * d0 + d1 * d1; }
        s2 += shfl_xor_f(s2, 32, lane);
        const float rstd = rsqrtf(s2 * (1.0f / 64.0f) + EPS);
        const float* gn = a.in[11] + l * 256 + h * 64;
        const h16* gp = (const h16*)(ws + WS_Z) + (size_t)(b * SEQ + qrow) * DINP + C_RG + h * 64;
#pragma unroll
        for (int mtv = 0; mtv < 2; ++mtv)
#pragma unroll
            for (int i4 = 0; i4 < 4; ++i4) { const int dv = 32 * mtv + 8 * i4 + 4 * hi;
                const half4 gg = *(const half4*)(gp + dv); const f32x4 gnv = *(const f32x4*)(gn + dv); half4 w;
#pragma unroll
                for (int j = 0; j < 4; ++j) w[j] = (h16)(siluf((float)gg[j]) * (oacc[mtv][4 * i4 + j] - mu) * rstd * gnv[j]);
                *(half4*)(Y + 384 + h * 64 + dv) = w; }
    }
}

DI float gelu_tanh(float x) { const float u = 0.7978845608028654f * (x + 0.044715f * x * x * x); const float t = 1.0f - 2.0f * __builtin_amdgcn_rcpf(1.0f + __expf(2.0f * u)); return 0.5f * x * (1.0f + t); }
DI float sigmoidf_(float v) { return __builtin_amdgcn_rcpf(1.0f + __expf(-v)); }
DI float neg_expm1(float x) { const float big = 1.0f - __expf(x); const float sm = -x * (1.0f + x * (0.5f + x * (0.16666667f + x * 0.041666668f))); return (x > -0.1f) ? sm : big; }
DI void lru_unit(const Args& a, int l, int b, int g, LAS unsigned char* lds, const int WID_) {
    const int tid = tid_opaque(WID_), lane = tid & 63, wave = WID_, l32 = lane & 31, hi = lane >> 5;
    unsigned char* ws = a.ws;
    const h16* Z = (const h16*)(ws + WS_Z) + (size_t)b * SEQ * DINP;
    h16* Y = (h16*)(ws + WS_H) + (size_t)b * SEQ * D + 640 + 64 * g + lane;
    const int ch = 64 * g + lane;
    const float cw0 = a.in[12][(l * 4 + 0) * 384 + ch], cw1 = a.in[12][(l * 4 + 1) * 384 + ch], cw2 = a.in[12][(l * 4 + 2) * 384 + ch], cw3 = a.in[12][(l * 4 + 3) * 384 + ch];
    const float cb = a.in[13][l * 384 + ch], ba = a.in[15][l * 384 + ch], bi = a.in[17][l * 384 + ch];
    const float lam = a.in[18][l * 384 + ch];
    const float sp8 = 8.0f * log1pf(expf(-lam));
    const h16* WA = (const h16*)(ws + WS_LRUW) + (size_t)((l * 2 + 0) * 6 + g) * 4096;
    const h16* WI = (const h16*)(ws + WS_LRUW) + (size_t)((l * 2 + 1) * 6 + g) * 4096;
    LAS unsigned char* reg = lds + wave * 16384;
    LAS float* Rb = (LAS float*)reg; LAS float* Ib = (LAS float*)(reg + 8192);
    LAS float* cA = (LAS float*)(lds + 131072); LAS float* cH = (LAS float*)(lds + 131072 + 2048);
    float h_round = 0.f;
    for (int rd = 0; rd < 8; ++rd) {
        const int t0 = rd * 256 + wave * 32;
        h16 gvh[32];
        {
            const h16* ug = Z + C_UG + ch;
#pragma unroll
            for (int t = 0; t < 32; ++t) gvh[t] = ug[(size_t)(t0 + t) * DINP];
        }
        half8 wfa[2][4], wfi[2][4];
#pragma unroll
        for (int nt = 0; nt < 2; ++nt)
#pragma unroll
            for (int s = 0; s < 4; ++s) { wfa[nt][s] = *(const half8*)(WA + (32 * nt + l32) * 64 + 16 * s + 8 * hi); wfi[nt][s] = *(const half8*)(WI + (32 * nt + l32) * 64 + 16 * s + 8 * hi); }
        float xc[32];
        {
            const h16* ux = Z + C_UX + ch;
            float xm3 = 0.f, xm2 = 0.f, xm1 = 0.f;
            if (t0 > 0) { xm3 = (float)ux[(size_t)(t0 - 3) * DINP]; xm2 = (float)ux[(size_t)(t0 - 2) * DINP]; xm1 = (float)ux[(size_t)(t0 - 1) * DINP]; }
            float xv[32];
#pragma unroll
            for (int t = 0; t < 32; ++t) xv[t] = (float)ux[(size_t)(t0 + t) * DINP];
#pragma unroll
            for (int t = 0; t < 32; ++t) { const float v = cb + cw0 * xm3 + cw1 * xm2 + cw2 * xm1 + cw3 * xv[t]; xc[t] = v; xm3 = xm2; xm2 = xm1; xm1 = xv[t];
                *(LAS h16*)(reg + t * 144 + lane * 2) = (h16)v; }
        }
        __syncthreads();
        {
            half8 xa[4];
#pragma unroll
            for (int s = 0; s < 4; ++s) xa[s] = *(const LAS half8*)(reg + l32 * 144 + (16 * s + 8 * hi) * 2);
            f32x16 ra[2], ia[2];
#pragma unroll
            for (int nt = 0; nt < 2; ++nt) {
#pragma unroll
                for (int i = 0; i < 16; ++i) { ra[nt][i] = 0.f; ia[nt][i] = 0.f; }
#pragma unroll
                for (int s = 0; s < 4; ++s) { ra[nt] = __builtin_amdgcn_mfma_f32_32x32x16_f16(xa[s], wfa[nt][s], ra[nt], 0, 0, 0); ia[nt] = __builtin_amdgcn_mfma_f32_32x32x16_f16(xa[s], wfi[nt][s], ia[nt], 0, 0, 0); }
            }
            __syncthreads();
#pragma unroll
            for (int nt = 0; nt < 2; ++nt)
#pragma unroll
                for (int i = 0; i < 16; ++i) { const int t = crow(i, hi); Rb[t * 64 + 32 * nt + l32] = ra[nt][i]; Ib[t * 64 + 32 * nt + l32] = ia[nt][i]; }
        }
        __syncthreads();
        float Ac = 1.f, hl = 0.f;
#pragma unroll
        for (int t = 0; t < 32; ++t) {
            const float ea = 1.0f + __expf(-(Rb[t * 64 + lane] + ba)), ei = 1.0f + __expf(-(Ib[t * 64 + lane] + bi));
            const float rc = __builtin_amdgcn_rcpf(ea * ei);
            const float r = ei * rc, ig = ea * rc;
            const float log_a = -sp8 * r;
            const float av = __expf(log_a);
            const float bv = __builtin_amdgcn_sqrtf(neg_expm1(2.0f * log_a)) * ig * xc[t];
            hl = av * hl + bv; Ac = Ac * av;
            Rb[t * 64 + lane] = Ac; Ib[t * 64 + lane] = hl;
        }
        cA[wave * 64 + lane] = Ac; cH[wave * 64 + lane] = hl;
        __syncthreads();
        float h_in = 0.f, hc = h_round;
#pragma unroll
        for (int w = 0; w < 8; ++w) { if (w == wave) h_in = hc; hc = cA[w * 64 + lane] * hc + cH[w * 64 + lane]; }
        h_round = hc;
        {
#pragma unroll
            for (int t = 0; t < 32; ++t) { const float hv = Ib[t * 64 + lane] + Rb[t * 64 + lane] * h_in; Y[(size_t)(t0 + t) * D] = (h16)(gelu_tanh((float)gvh[t]) * hv); }
        }
        __syncthreads();
    }
}

DI void mixer_phase(const Args& a, int lc, LAS unsigned char* lds, const int WID_) {
    const int l = lc & 3;
    unsigned* ctr = (unsigned*)(a.ws + WS_CTL) + 64 * lc;
    LAS unsigned* su = (LAS unsigned*)(lds + LDS_BYTES - 64);
    constexpr int NLRU = (PROBE_MODE == 6) ? 192 : 96;
    constexpr int NMLA = (PROBE_MODE == 7) ? 192 : 96, NRET = (PROBE_MODE == 8) ? 128 : 64, NSLOT = NMLA + NRET;
    constexpr int NUNITS = NLRU + 8 * NSLOT;
    for (;;) {
        if (tid_opaque(WID_) == 0) *su = atomicAdd(ctr, 1u);
        __syncthreads();
        const int u = (int)*su;
        __syncthreads();
        if (u >= NUNITS) break;
        if (u < NLRU) { const int uu = u % 96; lru_unit(a, l, uu / 6, uu % 6, lds, WID_); }
        else { const int v = u - NLRU, qs = v / NSLOT, w = v - qs * NSLOT, qb = 7 - qs;
            if (w < NMLA) { const int ww = w % 96; attn_unit<false>(a, l, ww / 6, ww % 6, qb, lds, WID_); }
            else { const int r = (w - NMLA) % 64; attn_unit<true>(a, l, r >> 2, r & 3, qb, lds, WID_); } }
        __syncthreads();
    }
}

DI void grid_bar(unsigned* ctr, unsigned target, const int WID_) {
    asm volatile("s_waitcnt vmcnt(0) lgkmcnt(0)" ::: "memory");
    __syncthreads();
    if (tid_opaque(WID_) == 0) {
        __builtin_amdgcn_fence(__ATOMIC_RELEASE, "agent");
        asm volatile("s_waitcnt vmcnt(0)" ::: "memory");
        (void)__hip_atomic_fetch_add(ctr, 1u, __ATOMIC_RELAXED, __HIP_MEMORY_SCOPE_AGENT);
        while (__hip_atomic_load(ctr, __ATOMIC_RELAXED, __HIP_MEMORY_SCOPE_AGENT) < target) __builtin_amdgcn_s_sleep(1);
        __builtin_amdgcn_fence(__ATOMIC_ACQUIRE, "agent");
        asm volatile("s_waitcnt vmcnt(0)" ::: "memory");
    }
    __syncthreads();
}

DI void grid_bar2(unsigned* ctl, unsigned k, unsigned x, unsigned nx, unsigned nxcd, const int WID_) {
    asm volatile("s_waitcnt vmcnt(0) lgkmcnt(0)" ::: "memory");
    __syncthreads();
    if (tid_opaque(WID_) == 0) {
        unsigned* A = ctl + 520 + 16 * x; unsigned* GC = ctl + 656; unsigned* R = ctl + 704 + 16 * x;
        __builtin_amdgcn_fence(__ATOMIC_RELEASE, "agent");
        asm volatile("s_waitcnt vmcnt(0)" ::: "memory");
        const unsigned old = __hip_atomic_fetch_add(A, 1u, __ATOMIC_RELAXED, __HIP_MEMORY_SCOPE_AGENT);
        unsigned sp = 0;
        if (old + 1u == k * nx) {
            (void)__hip_atomic_fetch_add(GC, 1u, __ATOMIC_RELAXED, __HIP_MEMORY_SCOPE_AGENT);
            while (__hip_atomic_load(GC, __ATOMIC_RELAXED, __HIP_MEMORY_SCOPE_AGENT) < k * nxcd) { __builtin_amdgcn_s_sleep(1); if (++sp > (1u << 22)) break; }
            __hip_atomic_store(R, k, __ATOMIC_RELAXED, __HIP_MEMORY_SCOPE_AGENT);
        } else {
            while (__hip_atomic_load(R, __ATOMIC_RELAXED, __HIP_MEMORY_SCOPE_AGENT) < k) { __builtin_amdgcn_s_sleep(1); if (++sp > (1u << 22)) break; }
        }
        __builtin_amdgcn_fence(__ATOMIC_ACQUIRE, "agent");
        asm volatile("s_waitcnt vmcnt(0)" ::: "memory");
    }
    __syncthreads();
}

__global__ void __launch_bounds__(NTHREADS, 2) hymba_fwd(Args a_unused) {
    extern __shared__ __attribute__((aligned(16))) unsigned char lds_raw[];
    LAS unsigned char* lds = (LAS unsigned char*)lds_raw;
    cg::grid_group grid = cg::this_grid();
    const int WID_ = __builtin_amdgcn_readfirstlane((int)(threadIdx.x >> 6));
    int l = 0, nbar = 0;
    const unsigned XCC_ = (unsigned)__builtin_amdgcn_s_getreg((3 << 11) | 20) & 7u;
    if (threadIdx.x == 0) (void)__hip_atomic_fetch_add((unsigned*)(args_opaque()->ws + WS_CTL) + 832 + 16 * XCC_, 1u, __ATOMIC_RELAXED, __HIP_MEMORY_SCOPE_AGENT);
    unsigned NX_ = 0, NXCD_ = 0;
#define PHASE_BEGIN(KIND) { const int nrep = (PROBE_MODE != 0 && PROBE_MODE == (KIND)) ? 2 : 1; for (int rep = 0; rep < nrep; ++rep) { const ArgsP ap = args_opaque(); const int BID = bid_opaque(), G = gdim_opaque(); (void)BID; (void)G; const Args a = load_args(ap); unsigned char* ws = a.ws; const float* modv = (const float*)(ws + WS_MOD); const float* modl = modv + (size_t)l * 16 * 6144; h16* XH = (h16*)(ws + WS_XH); float* RSS = (float*)(ws + WS_RSS); (void)RSS; \
    h16* H = (h16*)(ws + WS_H); h16* Z = (h16*)(ws + WS_Z); h16* HID = (h16*)(ws + WS_HID); (void)modl; (void)XH; (void)H; (void)Z; (void)HID;
#define PHASE_END_(LAST)   if (rep + 1 < nrep || !LAST) { if (gdim_opaque() == 0x7fffffff) grid.sync(); ++nbar; \
        if (nbar == 1) { grid_bar((unsigned*)(args_opaque()->ws + WS_CTL) + 512, (unsigned)gdim_opaque(), WID_); \
            unsigned* cen = (unsigned*)(args_opaque()->ws + WS_CTL) + 832; unsigned nn = 0; \
            for (int xx = 0; xx < 8; ++xx) { const unsigned cv = __hip_atomic_load(cen + 16 * xx, __ATOMIC_RELAXED, __HIP_MEMORY_SCOPE_AGENT); nn += cv ? 1u : 0u; if ((unsigned)xx == XCC_) NX_ = cv; } \
            NX_ = __builtin_amdgcn_readfirstlane(NX_); NXCD_ = __builtin_amdgcn_readfirstlane(nn); } \
        else grid_bar2((unsigned*)(args_opaque()->ws + WS_CTL), (unsigned)(nbar - 1), XCC_, NX_, NXCD_, WID_); } \
    if (PROBE_MODE == 5) { ++nbar; grid_bar2((unsigned*)(args_opaque()->ws + WS_CTL), (unsigned)(nbar - 1), XCC_, NX_, NXCD_, WID_); } } }
#define PHASE_END PHASE_END_(false)

    PHASE_BEGIN(1) p0_prologue(a, lds, WID_); PHASE_END
    PHASE_BEGIN(0) p0b_phase(a, lds, WID_); PHASE_END

    for (l = 0; l < DEPTH; ++l) {
        PHASE_BEGIN(2) { pg8::Gemm g{H, (const h16*)(ws + WS_WIN + l * WIN_STRIDE), T, DINP, D}; pg8::StaticOrder S; S.init(T, DINP, G, BID, D);
            EpiZ E{Z, DINP, RSS + (size_t)(2 * l) * T, (const float*)(ws + WS_B1) + (size_t)l * 16 * DINP, DINP}; pg8::gemm_phase<EpiZ, GEMM_ALIGN, GEMM_SP2>(lds, g, S, E, WID_); } PHASE_END
        PHASE_BEGIN(2) prep_phase(a, l, WID_); PHASE_END
        PHASE_BEGIN(2) { pg8::Gemm g{(const h16*)(ws + WS_CQKV), (const h16*)(ws + WS_WUP + l * WUP_STRIDE), T, NUP, KUP}; pg8::StaticOrder S; S.init(T, NUP, G, BID, KUP, 1);
            EpiF16 E{(h16*)(ws + WS_UP), NUP}; pg8::gemm_phase<EpiF16, GEMM_ALIGN, GEMM_SP2>(lds, g, S, E, WID_); } PHASE_END
        PHASE_BEGIN(3) mixer_phase(a, l + 4 * rep, lds, WID_); PHASE_END
#if PROBE_MODE == 9
        PHASE_BEGIN(0) { pg8::Gemm g{H, (const h16*)(ws + WS_WOUT + l * WOUT_STRIDE), T, D, D}; pg8::StaticOrder S; S.init(T, D, G, BID, D);
            EpiNull E{(float*)(ws + WS_CTL) + 768}; pg8::gemm_phase<EpiNull, GEMM_ALIGN, GEMM_SP2>(lds, g, S, E, WID_); } PHASE_END
#endif
        PHASE_BEGIN(0) { pg8::Gemm g{H, (const h16*)(ws + WS_WOUT + l * WOUT_STRIDE), T, D, D}; pg8::StaticOrder S; S.init(T, D, G, BID, D);
            EpiRes E{XH, modl + 2 * D, 6144, (h16*)(ws + WS_XG2), a.in[20] + l * D, modl + 4 * D, RSS + (size_t)(2 * l + 1) * T}; pg8::gemm_phase<EpiRes, GEMM_ALIGN, GEMM_SP2>(lds, g, S, E, WID_); } PHASE_END
        PHASE_BEGIN(4) { pg8::Gemm g{(const h16*)(ws + WS_XG2), (const h16*)(ws + WS_WGU + l * WGU_STRIDE), T, 2 * FFN, D}; pg8::StaticOrder S; S.init(T, 2 * FFN, G, BID, D);
            EpiSwiGLU E{HID, FFN, RSS + (size_t)(2 * l + 1) * T, (const float*)(ws + WS_B2) + (size_t)l * 16 * 2 * FFN}; pg8::gemm_phase<EpiSwiGLU, GEMM_ALIGN, GEMM_SP2>(lds, g, S, E, WID_); } PHASE_END
#if PROBE_MODE == 10
        PHASE_BEGIN(0) { pg8::Gemm g{HID, (const h16*)(ws + WS_WDN + l * WDN_STRIDE), T, D, FFN}; pg8::StaticOrder S; S.init(T, D, G, BID, FFN);
            EpiNull E{(float*)(ws + WS_CTL) + 768}; pg8::gemm_phase<EpiNull, GEMM_ALIGN, GEMM_SP2>(lds, g, S, E, WID_); } PHASE_END
#endif
        PHASE_BEGIN(0) { pg8::Gemm g{HID, (const h16*)(ws + WS_WDN + l * WDN_STRIDE), T, D, FFN}; pg8::StaticOrder S; S.init(T, D, G, BID, FFN);
            const int ln = (l + 1 < DEPTH) ? l + 1 : l;
            EpiRes E{XH, modl + 5 * D, 6144, (l + 1 < DEPTH) ? H : (h16*)nullptr, a.in[5] + ln * D, modv + (size_t)ln * 16 * 6144 + 1 * D, RSS + (size_t)(2 * l + 2) * T}; pg8::gemm_phase<EpiRes, GEMM_ALIGN, GEMM_SP2>(lds, g, S, E, WID_); } PHASE_END
    }
    PHASE_BEGIN(0) final_phase(a, WID_); PHASE_END_(true)
#undef PHASE_BEGIN
#undef PHASE_END
#undef PHASE_END_
}

extern "C" void kernel_launch(void* const* d_in, const int* in_sizes, int n_in, void* d_out, int out_size, void* d_ws, size_t ws_size, hipStream_t stream) {
    static int grid = 0;
    if (grid == 0) {
        if (n_in != 26 || out_size != T * D || ws_size < WS_END) { fprintf(stderr, "kernel_launch: unexpected shapes (n_in %d out %d ws %zu)\n", n_in, out_size, ws_size); grid = -1; return; }
        int dev = 0, cus = 0, per_cu = 0;
        hipGetDevice(&dev); hipDeviceGetAttribute(&cus, hipDeviceAttributeMultiprocessorCount, dev);
        if (hipFuncSetAttribute((const void*)hymba_fwd, hipFuncAttributeMaxDynamicSharedMemorySize, LDS_BYTES) != hipSuccess) { fprintf(stderr, "kernel_launch: hipFuncSetAttribute failed\n"); grid = -1; return; }
        if (hipOccupancyMaxActiveBlocksPerMultiprocessor(&per_cu, (const void*)hymba_fwd, NTHREADS, LDS_BYTES) != hipSuccess || per_cu < 1) { fprintf(stderr, "kernel_launch: occupancy query gave %d\n", per_cu); per_cu = 1; }
        (void)hipGetLastError();
        grid = cus * 1;
    }
    if (grid < 0) return;
    hipMemsetAsync((char*)d_ws + WS_CTL, 0, CTL_BYTES, stream);
    Args a{};
    for (int i = 0; i < 26; ++i) a.in[i] = (const float*)d_in[i];
    a.out = (float*)d_out; a.ws = (unsigned char*)d_ws; a.ph_lo = 0; a.ph_hi = 1 << 20;
    void* kargs[] = {&a};
    hipError_t e = hipLaunchCooperativeKernel((const void*)hymba_fwd, dim3(grid), dim3(NTHREADS), kargs, LDS_BYTES, stream);
    if (e != hipSuccess) fprintf(stderr, "kernel_launch: cooperative launch failed: %s (grid %d)\n", hipGetErrorString(e), grid);
}
```

```cpp
#include <hip/hip_runtime.h>
#include <hip/hip_cooperative_groups.h>
#include <cstdio>
#include <cstdint>
namespace cg = cooperative_groups;

#define LAS __attribute__((address_space(3)))
#define DI __device__ __forceinline__
typedef _Float16 h16;
typedef _Float16 half8 __attribute__((ext_vector_type(8)));
typedef _Float16 half4 __attribute__((ext_vector_type(4)));
typedef _Float16 half2v __attribute__((ext_vector_type(2)));
typedef short s16x4 __attribute__((ext_vector_type(4)));
typedef float f32x2 __attribute__((ext_vector_type(2)));
typedef float f32x4 __attribute__((ext_vector_type(4)));
typedef float f32x16 __attribute__((ext_vector_type(16)));

constexpr int D = 1024, NB = 16, SEQ = 2048, T = NB * SEQ, DEPTH = 4;
constexpr int DIN = 1952, DINP = 2048, FFN = 2816, NMOD = 6;
constexpr int KUP = 384, NUP = 1536;
constexpr int C_CQ = 0, C_CKV = 256, C_KR = 384, C_RQ = 416, C_RK = 544, C_RV = 672, C_RG = 928, C_UX = 1184, C_UG = 1568;
constexpr float EPS = 1e-6f;

constexpr size_t MiB = 1u << 20;
constexpr size_t WS_CTL = 0, CTL_BYTES = 4096;
constexpr size_t WS_MOD = 1 * MiB;
constexpr size_t WS_FMOD = 1 * MiB + 1536 * 1024 + 0;
constexpr size_t WS_CS = 3 * MiB;
constexpr size_t WS_LRUW = 7 * MiB;
constexpr size_t WS_WIN = 8 * MiB, WIN_STRIDE = 4 * MiB;
constexpr size_t WS_WUP = 24 * MiB, WUP_STRIDE = 2 * MiB;
constexpr size_t WS_WOUT = 32 * MiB, WOUT_STRIDE = 2 * MiB;
constexpr size_t WS_WGU = 40 * MiB, WGU_STRIDE = 11 * MiB;
constexpr size_t WS_WDN = 84 * MiB, WDN_STRIDE = 5632 * 1024;
constexpr size_t WS_H = 106 * MiB;
constexpr size_t WS_Z = 170 * MiB;
constexpr size_t WS_CQKV = 298 * MiB;
constexpr size_t WS_UP = 322 * MiB;
constexpr size_t WS_KR = 434 * MiB;
constexpr size_t WS_RQ = 418 * MiB;
constexpr size_t WS_RK = 426 * MiB;
constexpr size_t WS_HID = 170 * MiB;
constexpr size_t WS_XH = 436 * MiB;
constexpr size_t WS_XG2 = 346 * MiB;
constexpr size_t WS_RSS = 500 * MiB;
constexpr size_t WS_B1 = 502 * MiB;
constexpr size_t WS_B2 = 502 * MiB + 512 * 1024;
constexpr size_t WS_END = 504 * MiB;
static_assert(WS_HID + (size_t)T * FFN * 2 <= WS_XG2 && WS_XG2 + (size_t)T * D * 2 <= WS_RQ, "xg2 placement");
static_assert(WS_HID + (size_t)T * FFN * 2 <= WS_RQ, "hid overlay");

#ifndef PROBE_MODE
#define PROBE_MODE 0
#endif
#ifndef GEMM_SP2
#define GEMM_SP2 true
#endif
#ifndef GEMM_ALIGN
#define GEMM_ALIGN true
#endif
constexpr int LDS_BYTES = 147456;
constexpr int NTHREADS = 512;

struct Args { const float* in[26]; float* out; unsigned char* ws; int ph_lo, ph_hi; };

typedef const __attribute__((address_space(4))) Args* ArgsP;
DI ArgsP args_opaque() { ArgsP p = (ArgsP)__builtin_amdgcn_kernarg_segment_ptr(); asm volatile("" : "+s"(p)); return p; }
DI Args load_args(ArgsP p) { Args a;
#pragma unroll
    for (int i = 0; i < 26; ++i) a.in[i] = p->in[i];
    a.out = p->out; a.ws = p->ws; a.ph_lo = 0; a.ph_hi = 0; return a; }
DI int bid_opaque() { int b = blockIdx.x; asm volatile("" : "+s"(b)); return b; }
DI int gdim_opaque() { int b = gridDim.x; asm volatile("" : "+s"(b)); return b; }
DI int tid_opaque(int wid) { int t = wid * 64 + (int)__builtin_amdgcn_mbcnt_hi(~0u, __builtin_amdgcn_mbcnt_lo(~0u, 0u)); asm volatile("" : "+v"(t)); return t; }

namespace pg8 {
constexpr int BM = 256, BK = 64, HALF = 128, HTB = HALF * BK * 2, STAGE_BYTES = 8 * HTB, NXCD = 8, WGM = 8;
__host__ __device__ __forceinline__ int lds_byte(int r, int c) { const int st = (r >> 4) * 2 + (c >> 5), rr = r & 15, cc = c & 31, ob = rr * 64 + cc * 2; return st * 1024 + (ob ^ (((ob >> 9) & 1) << 5)); }
__host__ __device__ __forceinline__ void stage_rc(int b, int& R, int& C) { const int st = b / 1024, sb = b % 1024, swz = sb ^ (((sb >> 9) & 1) << 5); R = (st >> 1) * 16 + swz / 64; C = (st & 1) * 32 + (swz % 64) / 2; }
__host__ __device__ __forceinline__ int perm32(int rho) { const int n = rho >> 4, i = rho & 15; return 8 * (i >> 2) + 4 * n + (i & 3); }
struct Unit { int pm, pn, kb, nk; };
struct Gemm { const h16* A; const h16* Bt; int M, N, K; };
struct StaticOrder {
    int nM, nN, nwg, G, c, ntk, kmode;
    __device__ void init(int M, int N, int G_, int c_, int K = 0, int kmode_ = 0) { nM = M / BM; nN = N / BM; nwg = nM * nN; G = G_; c = c_; ntk = K / BK; kmode = kmode_; }
    __device__ bool next(int i, Unit& u) const {
        const long L = (long)i * G + c; if (L >= nwg) return false;
        int wgid = (int)L; { const int q = nwg / NXCD, r = nwg % NXCD, xcd = wgid % NXCD, off = wgid / NXCD; wgid = (xcd < r ? xcd * (q + 1) : r * (q + 1) + (xcd - r) * q) + off; }
        const int nig = WGM * nN, gid = wgid / nig, fm = gid * WGM, gsz = (nM - fm) < WGM ? (nM - fm) : WGM;
        u.pm = fm + ((wgid % nig) % gsz); u.pn = (wgid % nig) / gsz;
        if (kmode == 1) { if (u.pn <= 1) { u.kb = 0; u.nk = 4; } else if (u.pn == 2) { u.kb = 0; u.nk = 6; } else { u.kb = 4; u.nk = 2; } }
        else { u.kb = 0; u.nk = ntk; }
        return true;
    }
};
template <class Epi, bool ALIGN_EPI = false, bool SP2 = false>
__device__ __forceinline__ void gemm_phase(LAS unsigned char* lds, const Gemm g, const StaticOrder& S, const Epi& E, const int WID_) {
    const int tid = tid_opaque(WID_), wid = __builtin_amdgcn_readfirstlane(tid >> 6), lane = tid & 63, wr = wid >> 2, wc = wid & 3, fr = lane & 15, fq = lane >> 4;
    int K_ = g.K; asm volatile("" : "+s"(K_));
    const int K = K_, nt = K / BK;
    unsigned voffA[2], voffB[2];
#pragma unroll
    for (int i = 0; i < 2; ++i) { int R, C; stage_rc(tid * 16 + i * 8192, R, C); const int Rb = Epi::PERM ? ((R & ~31) + perm32(R & 31)) : R;
        voffA[i] = (unsigned)(R * K + C) * 2u; voffB[i] = (unsigned)(Rb * K + C) * 2u; }
    const size_t kstep = (size_t)(BK * 2);
    const size_t hstep = (size_t)HALF * K * 2;
    const size_t tstep = 2 * hstep;
    const unsigned ldsw = (unsigned)wid * 1024u;
    const int aoff = lds_byte(wr * 64 + fr, fq * 8), boff = lds_byte(wc * 32 + fr, fq * 8);
#define PG8_SA(b, h) (((b) * 2 + (h)) * HTB)
#define PG8_SB(b, h) ((4 + (b) * 2 + (h)) * HTB)
#define PG8_STAGE(bufoff, gbase, voff) do { _Pragma("unroll") for (int _i = 0; _i < 2; ++_i) \
        __builtin_amdgcn_global_load_lds((const unsigned*)((const char*)(gbase) + (voff)[_i]), (LAS unsigned*)(lds + (bufoff) + ldsw + _i * 8192), 16, 0, 0); } while (0)
#define PG8_LDA(dst, b, h) do { _Pragma("unroll") for (int m = 0; m < 4; ++m) _Pragma("unroll") for (int k = 0; k < 2; ++k) dst[m][k] = *(const LAS half8*)(lds + PG8_SA(b, h) + aoff + m * 2048 + k * 1024); } while (0)
#define PG8_LDB(dst, b, h) do { _Pragma("unroll") for (int n = 0; n < 2; ++n) _Pragma("unroll") for (int k = 0; k < 2; ++k) dst[n][k] = *(const LAS half8*)(lds + PG8_SB(b, h) + boff + n * 2048 + k * 1024); } while (0)
#define PG8_MMA(ai, bj, At, Bt) do { __builtin_amdgcn_s_setprio(1); _Pragma("unroll") for (int m = 0; m < 4; ++m) _Pragma("unroll") for (int n = 0; n < 2; ++n) _Pragma("unroll") for (int k = 0; k < 2; ++k) \
        acc[ai][bj][m][n] = __builtin_amdgcn_mfma_f32_16x16x32_f16(Bt[n][k], At[m][k], acc[ai][bj][m][n], 0, 0, 0); __builtin_amdgcn_s_setprio(0); } while (0)
#define PG8_WAIT_V(n) asm volatile("s_waitcnt vmcnt(" #n ")" ::: "memory")
#define PG8_WAIT_L(n) asm volatile("s_waitcnt lgkmcnt(" #n ")" ::: "memory")
#define PG8_BAR __builtin_amdgcn_s_barrier()
#define PG8_SCHED __builtin_amdgcn_sched_barrier(0)
    Unit cur, nxt; int ui = 0;
    if (!S.next(0, cur)) return;
    f32x4 acc[2][2][4][2];
#pragma unroll
    for (int a = 0; a < 2; ++a)
#pragma unroll
        for (int b = 0; b < 2; ++b)
#pragma unroll
            for (int m = 0; m < 4; ++m)
#pragma unroll
                for (int n = 0; n < 2; ++n) acc[a][b][m][n] = (f32x4){0.f, 0.f, 0.f, 0.f};
    half8 At[4][2], B0[2][2], B1[2][2];
    const char* cA = (const char*)g.A + (size_t)cur.pm * tstep + (size_t)cur.kb * kstep; const char* cB = (const char*)g.Bt + (size_t)cur.pn * tstep + (size_t)cur.kb * kstep;
    if constexpr (SP2) {
        PG8_STAGE(PG8_SB(0, 0), cB, voffB); PG8_STAGE(PG8_SB(0, 1), cB + hstep, voffB); PG8_STAGE(PG8_SA(0, 0), cA, voffA); PG8_STAGE(PG8_SA(0, 1), cA + hstep, voffA);
        if (wr == 1) PG8_BAR;
        PG8_WAIT_V(2); PG8_BAR;
        PG8_STAGE(PG8_SB(1, 0), cB + kstep, voffB); PG8_STAGE(PG8_SA(1, 0), cA + kstep, voffA); PG8_STAGE(PG8_SB(1, 1), cB + hstep + kstep, voffB);
        PG8_WAIT_V(6); PG8_BAR;
    } else {
    PG8_STAGE(PG8_SB(0, 0), cB, voffB); PG8_STAGE(PG8_SA(0, 0), cA, voffA); PG8_STAGE(PG8_SB(0, 1), cB + hstep, voffB); PG8_STAGE(PG8_SA(0, 1), cA + hstep, voffA);
    if (wr == 1) PG8_BAR;
    PG8_WAIT_V(4); PG8_BAR;
    PG8_STAGE(PG8_SB(1, 0), cB + kstep, voffB); PG8_STAGE(PG8_SA(1, 0), cA + kstep, voffA); PG8_STAGE(PG8_SB(1, 1), cB + hstep + kstep, voffB);
    PG8_WAIT_V(6); PG8_BAR;
    }
    for (;;) {
        const bool has_next = S.next(ui + 1, nxt);
        const char* nA = has_next ? (const char*)g.A + (size_t)nxt.pm * tstep + (size_t)nxt.kb * kstep : cA; const char* nB = has_next ? (const char*)g.Bt + (size_t)nxt.pn * tstep + (size_t)nxt.kb * kstep : cB;
        const int ntu = cur.nk;
        for (int t = 0; t < ntu; t += 2) {
            const bool last = (t == ntu - 2);
            const char* a1 = cA + (size_t)(t + 1) * kstep;
            const char* a2 = last ? nA : cA + (size_t)(t + 2) * kstep; const char* b2 = last ? nB : cB + (size_t)(t + 2) * kstep;
            const char* a3 = a2 + kstep; const char* b3 = b2 + kstep;
            if constexpr (SP2) {
            PG8_LDB(B0, 0, 0); PG8_LDB(B1, 0, 1); PG8_SCHED; PG8_LDA(At, 0, 0); PG8_STAGE(PG8_SA(1, 1), a1 + hstep, voffA);
            PG8_WAIT_V(8); PG8_WAIT_L(0); PG8_BAR; PG8_MMA(0, 0, At, B0); PG8_MMA(0, 1, At, B1); PG8_BAR; PG8_SCHED;
            PG8_LDA(At, 0, 1); PG8_STAGE(PG8_SB(0, 0), b2, voffB); PG8_STAGE(PG8_SB(0, 1), b2 + hstep, voffB); PG8_STAGE(PG8_SA(0, 0), a2, voffA);
            PG8_WAIT_V(8); PG8_WAIT_L(0); PG8_BAR; PG8_MMA(1, 0, At, B0); PG8_MMA(1, 1, At, B1); PG8_BAR; PG8_SCHED;
            PG8_LDB(B0, 1, 0); PG8_LDB(B1, 1, 1); PG8_SCHED; PG8_LDA(At, 1, 0); PG8_STAGE(PG8_SA(0, 1), a2 + hstep, voffA);
            PG8_WAIT_V(8); PG8_WAIT_L(0); PG8_BAR; PG8_MMA(0, 0, At, B0); PG8_MMA(0, 1, At, B1); PG8_BAR; PG8_SCHED;
            PG8_LDA(At, 1, 1); PG8_STAGE(PG8_SB(1, 0), b3, voffB); PG8_STAGE(PG8_SB(1, 1), b3 + hstep, voffB); PG8_STAGE(PG8_SA(1, 0), a3, voffA);
            PG8_WAIT_V(8); PG8_WAIT_L(0); PG8_BAR; PG8_MMA(1, 0, At, B0); PG8_MMA(1, 1, At, B1); PG8_BAR; PG8_SCHED;
            } else {
            PG8_LDB(B0, 0, 0); PG8_SCHED; PG8_LDA(At, 0, 0); PG8_STAGE(PG8_SA(1, 1), a1 + hstep, voffA);
            PG8_WAIT_L(8); PG8_BAR; PG8_WAIT_L(0); PG8_MMA(0, 0, At, B0); PG8_BAR; PG8_SCHED;
            PG8_LDB(B1, 0, 1); PG8_STAGE(PG8_SB(0, 0), b2, voffB);
            PG8_BAR; PG8_WAIT_L(0); PG8_MMA(0, 1, At, B1); PG8_BAR;
            PG8_LDA(At, 0, 1); PG8_STAGE(PG8_SA(0, 0), a2, voffA);
            PG8_BAR; PG8_WAIT_L(0); PG8_MMA(1, 0, At, B0); PG8_BAR; PG8_SCHED;
            PG8_STAGE(PG8_SB(0, 1), b2 + hstep, voffB);
            PG8_WAIT_V(6); PG8_BAR; PG8_MMA(1, 1, At, B1); PG8_BAR;
            PG8_LDB(B0, 1, 0); PG8_SCHED; PG8_LDA(At, 1, 0); PG8_STAGE(PG8_SA(0, 1), a2 + hstep, voffA);
            PG8_WAIT_L(8); PG8_BAR; PG8_WAIT_L(0); PG8_MMA(0, 0, At, B0); PG8_BAR; PG8_SCHED;
            PG8_LDB(B1, 1, 1); PG8_STAGE(PG8_SB(1, 0), b3, voffB);
            PG8_BAR; PG8_WAIT_L(0); PG8_MMA(0, 1, At, B1); PG8_BAR;
            PG8_LDA(At, 1, 1); PG8_STAGE(PG8_SA(1, 0), a3, voffA);
            PG8_BAR; PG8_WAIT_L(0); PG8_MMA(1, 0, At, B0); PG8_BAR; PG8_SCHED;
            PG8_STAGE(PG8_SB(1, 1), b3 + hstep, voffB);
            PG8_WAIT_V(6); PG8_BAR; PG8_MMA(1, 1, At, B1); PG8_BAR;
                    }
        }
        if constexpr (ALIGN_EPI) { if (wr == 0) PG8_BAR; }
        E(acc, cur, wr, wc, fr, fq);
        if (!has_next) break;
#pragma unroll
        for (int a = 0; a < 2; ++a)
#pragma unroll
            for (int b = 0; b < 2; ++b)
#pragma unroll
                for (int m = 0; m < 4; ++m)
#pragma unroll
                    for (int n = 0; n < 2; ++n) acc[a][b][m][n] = (f32x4){0.f, 0.f, 0.f, 0.f};
        cur = nxt; cA = nA; cB = nB; ++ui;
        if constexpr (ALIGN_EPI) { if (wr == 1) PG8_BAR; }
    }
    PG8_WAIT_V(0);
    if constexpr (!ALIGN_EPI) { if (wr == 0) PG8_BAR; }
    PG8_BAR;
#undef PG8_SA
#undef PG8_SB
#undef PG8_STAGE
#undef PG8_LDA
#undef PG8_LDB
#undef PG8_MMA
#undef PG8_WAIT_V
#undef PG8_WAIT_L
#undef PG8_BAR
#undef PG8_SCHED
}
}

DI half4 cvt4(f32x4 v) { half4 r; r[0] = (h16)v[0]; r[1] = (h16)v[1]; r[2] = (h16)v[2]; r[3] = (h16)v[3]; return r; }
DI float siluf(float v) { return v * __builtin_amdgcn_rcpf(1.0f + __expf(-v)); }

struct EpiF16 {
    static constexpr bool PERM = true;
    h16* O; int ldc;
    DI void operator()(const f32x4 (&acc)[2][2][4][2], const pg8::Unit& u, int wr, int wc, int fr, int fq) const {
        const int row0 = u.pm * 256 + wr * 64 + fr, col0 = u.pn * 256 + wc * 32 + 8 * fq;
#pragma unroll
        for (int ai = 0; ai < 2; ++ai)
#pragma unroll
            for (int m = 0; m < 4; ++m) { h16* rowp = O + (size_t)(row0 + ai * 128 + m * 16) * ldc + col0;
#pragma unroll
                for (int bj = 0; bj < 2; ++bj) { half8 w; const f32x4 v0 = acc[ai][bj][m][0], v1 = acc[ai][bj][m][1];
                    w[0] = (h16)v0[0]; w[1] = (h16)v0[1]; w[2] = (h16)v0[2]; w[3] = (h16)v0[3]; w[4] = (h16)v1[0]; w[5] = (h16)v1[1]; w[6] = (h16)v1[2]; w[7] = (h16)v1[3];
                    *(half8*)(rowp + bj * 128) = w; } }
    }
};
DI float shfl_xor_f(float v, int o, int lane) { return __builtin_bit_cast(float, __builtin_amdgcn_ds_bpermute((lane ^ o) << 2, __builtin_bit_cast(int, v))); }
struct EpiZ {
    static constexpr bool PERM = true;
    h16* O; int ldc; const float* rss; const float* bias; int ldb;
    DI void operator()(const f32x4 (&acc)[2][2][4][2], const pg8::Unit& u, int wr, int wc, int fr, int fq) const {
        const int row0 = u.pm * 256 + wr * 64 + fr, col0 = u.pn * 256 + wc * 32 + 8 * fq;
        const int b = (u.pm * 256) >> 11;
        f32x4 bv[2][2];
#pragma unroll
        for (int bj = 0; bj < 2; ++bj)
#pragma unroll
            for (int n = 0; n < 2; ++n) bv[bj][n] = *(const f32x4*)(bias + (size_t)b * ldb + col0 + bj * 128 + 4 * n);
#pragma unroll
        for (int ai = 0; ai < 2; ++ai)
#pragma unroll
            for (int m = 0; m < 4; ++m) { const int row = row0 + ai * 128 + m * 16; const float rstd = rsqrtf(rss[row] * (1.0f / D) + EPS);
                h16* rowp = O + (size_t)row * ldc + col0;
#pragma unroll
                for (int bj = 0; bj < 2; ++bj) { half8 w;
#pragma unroll
                    for (int n = 0; n < 2; ++n)
#pragma unroll
                        for (int j = 0; j < 4; ++j) w[4 * n + j] = (h16)(acc[ai][bj][m][n][j] * rstd + bv[bj][n][j]);
                    *(half8*)(rowp + bj * 128) = w; } }
    }
};
struct EpiSwiGLU {
    static constexpr bool PERM = true;
    h16* O; int ldc; const float* rss; const float* bias;
    DI void operator()(const f32x4 (&acc)[2][2][4][2], const pg8::Unit& u, int wr, int wc, int fr, int fq) const {
        const int row0 = u.pm * 256 + wr * 64 + fr, col0 = u.pn * 128 + wc * 32 + 8 * fq;
        const int b = (u.pm * 256) >> 11;
        f32x4 bg[2], bu[2];
#pragma unroll
        for (int n = 0; n < 2; ++n) { bg[n] = *(const f32x4*)(bias + (size_t)b * (2 * FFN) + col0 + 4 * n); bu[n] = *(const f32x4*)(bias + (size_t)b * (2 * FFN) + FFN + col0 + 4 * n); }
#pragma unroll
        for (int ai = 0; ai < 2; ++ai)
#pragma unroll
            for (int m = 0; m < 4; ++m) { const int row = row0 + ai * 128 + m * 16; const float rstd = rsqrtf(rss[row] * (1.0f / D) + EPS); half8 w;
#pragma unroll
                for (int n = 0; n < 2; ++n)
#pragma unroll
                    for (int j = 0; j < 4; ++j) { const float gt = acc[ai][0][m][n][j] * rstd + bg[n][j], up = acc[ai][1][m][n][j] * rstd + bu[n][j]; w[4 * n + j] = (h16)(siluf(gt) * up); }
                *(half8*)(O + (size_t)row * ldc + col0) = w; }
    }
};
struct EpiRes {
    static constexpr bool PERM = true;
    h16* x; const float* gate; int ldg; h16* xg; const float* gain; const float* sc; float* rss;
    DI void operator()(const f32x4 (&acc)[2][2][4][2], const pg8::Unit& u, int wr, int wc, int fr, int fq) const {
        const int row0 = u.pm * 256 + wr * 64 + fr, col0 = u.pn * 256 + wc * 32 + 8 * fq;
        const int b = (u.pm * 256) >> 11, lane = fr + 16 * fq;
        float ss[2][4];
#pragma unroll
        for (int ai = 0; ai < 2; ++ai)
#pragma unroll
            for (int m = 0; m < 4; ++m) ss[ai][m] = 0.f;
#pragma unroll
        for (int bj = 0; bj < 2; ++bj) {
            f32x4 gv[2], gm[2];
#pragma unroll
            for (int n = 0; n < 2; ++n) { gv[n] = *(const f32x4*)(gate + (size_t)b * ldg + col0 + bj * 128 + 4 * n);
                const f32x4 g4 = *(const f32x4*)(gain + col0 + bj * 128 + 4 * n), s4 = *(const f32x4*)(sc + (size_t)b * ldg + col0 + bj * 128 + 4 * n); gm[n] = g4 * (s4 + 1.0f); }
#pragma unroll
            for (int ai = 0; ai < 2; ++ai) {
                half8 xv[4];
#pragma unroll
                for (int m = 0; m < 4; ++m) xv[m] = *(const half8*)(x + (size_t)(row0 + ai * 128 + m * 16) * D + col0 + bj * 128);
                __builtin_amdgcn_sched_barrier(0);
#pragma unroll
                for (int m = 0; m < 4; ++m) { const int row = row0 + ai * 128 + m * 16; half8 w, wg; float s_ = 0.f;
#pragma unroll
                    for (int n = 0; n < 2; ++n)
#pragma unroll
                        for (int j = 0; j < 4; ++j) { const h16 hn = (h16)((float)xv[m][4 * n + j] + gv[n][j] * acc[ai][bj][m][n][j]); const float xr = (float)hn;
                            w[4 * n + j] = hn; s_ += xr * xr; wg[4 * n + j] = (h16)(xr * gm[n][j]); }
                    *(half8*)(x + (size_t)row * D + col0 + bj * 128) = w; ss[ai][m] += s_;
                    if (xg) *(half8*)(xg + (size_t)row * D + col0 + bj * 128) = wg; }
            }
        }
#pragma unroll
        for (int ai = 0; ai < 2; ++ai)
#pragma unroll
            for (int m = 0; m < 4; ++m) { float t = ss[ai][m]; t += shfl_xor_f(t, 16, lane); t += shfl_xor_f(t, 32, lane);
                if (fq == 0) unsafeAtomicAdd(rss + row0 + ai * 128 + m * 16, t); }
    }
};

struct EpiNull {
    static constexpr bool PERM = true;
    float* dummy;
    DI void operator()(const f32x4 (&acc)[2][2][4][2], const pg8::Unit& u, int wr, int wc, int fr, int fq) const {
        float t = 0.f;
#pragma unroll
        for (int ai = 0; ai < 2; ++ai)
#pragma unroll
            for (int bj = 0; bj < 2; ++bj)
#pragma unroll
                for (int m = 0; m < 4; ++m)
#pragma unroll
                    for (int n = 0; n < 2; ++n) t += acc[ai][bj][m][n][0] + acc[ai][bj][m][n][1] + acc[ai][bj][m][n][2] + acc[ai][bj][m][n][3];
        if (t == 1.2345678e33f) dummy[u.pm + wr + wc + fr + fq] = t;
    }
};
DI float wave_sum(float v, int lane) {
#pragma unroll
    for (int o = 32; o >= 1; o >>= 1) v += shfl_xor_f(v, o, lane);
    return v;
}
DI int crow(int reg, int hi) { return (reg & 3) + 8 * (reg >> 2) + 4 * hi; }

DI void xpose_tile(const float* __restrict__ src, int ld_src, int k0, int n0, int nvalid, h16* dst, int ldd, int dr0, int dk0, LAS float* scr, int lane, bool active) {
    if (active) {
#pragma unroll
        for (int hb = 0; hb < 2; ++hb) { float v[32];
#pragma unroll
            for (int i = 0; i < 32; ++i) { v[i] = 0.f; if (lane < nvalid) v[i] = src[(size_t)(k0 + 32 * hb + i) * ld_src + n0 + lane]; }
#pragma unroll
            for (int i = 0; i < 32; ++i) scr[(32 * hb + i) * 65 + lane] = v[i]; }
    }
    __syncthreads();
    if (active) {
        const int ic = lane & 7;
#pragma unroll
        for (int jj = 0; jj < 8; ++jj) { const int j = jj * 8 + (lane >> 3); half8 w;
#pragma unroll
            for (int e = 0; e < 8; ++e) w[e] = (h16)scr[(8 * ic + e) * 65 + j];
            *(half8*)(dst + (size_t)(dr0 + j) * ldd + dk0 + 8 * ic) = w; }
    }
    __syncthreads();
}

DI void p0_prologue(const Args& a, LAS unsigned char* lds, const int WID_) {
    const int tid = tid_opaque(WID_), lane = tid & 63, wave = tid >> 6;
    unsigned char* ws = a.ws;
    {
        LAS float* scr = (LAS float*)lds + wave * (64 * 65);
        constexpr int PER_LAYER = 512 + 144 + 256 + 1408 + 704 + 12;
        const int total = DEPTH * PER_LAYER, stride = gdim_opaque() * 8;
        for (int base = bid_opaque() * 8; base < total; base += stride) {
            const int id = base + wave; const bool active = id < total;
            const float* src = nullptr; int ld = 0, k0 = 0, n0 = 0, nvalid = 0, ldd = 0, dr0 = 0, dk0 = 0; h16* dst = nullptr;
            if (active) {
                const int l = id / PER_LAYER; int t = id - l * PER_LAYER;
                if (t < 512) { const int kt = t >> 5, nt = t & 31; src = a.in[6] + (size_t)l * D * DIN; ld = DIN; k0 = 64 * kt; n0 = 64 * nt; nvalid = DIN - n0; nvalid = nvalid < 0 ? 0 : (nvalid > 64 ? 64 : nvalid);
                    dst = (h16*)(ws + WS_WIN + l * WIN_STRIDE); ldd = D; dr0 = n0; dk0 = k0; }
                else if ((t -= 512) < 144) { const int kt = t / 24, nt = t - kt * 24; dst = (h16*)(ws + WS_WUP + l * WUP_STRIDE); ldd = KUP; dr0 = 64 * nt; dk0 = 64 * kt; nvalid = 0; src = a.in[8];
                    if (nt < 9) { if (kt < 4) { src = a.in[8] + (size_t)l * 256 * 576; ld = 576; k0 = 64 * kt; n0 = 64 * nt; nvalid = 64; } }
                    else if (nt < 21) { if (kt >= 4) { src = a.in[10] + (size_t)l * 128 * 768; ld = 768; k0 = 64 * (kt - 4); n0 = 64 * (nt - 9); nvalid = 64; } } }
                else if ((t -= 144) < 256) { const int kt = t >> 4, nt = t & 15; src = a.in[19] + (size_t)l * D * D; ld = D; k0 = 64 * kt; n0 = 64 * nt; nvalid = 64; dst = (h16*)(ws + WS_WOUT + l * WOUT_STRIDE); ldd = D; dr0 = n0; dk0 = k0; }
                else if ((t -= 256) < 1408) { const int kt = t / 88, nt = t - kt * 88; src = a.in[21] + (size_t)l * D * 2 * FFN; ld = 2 * FFN; k0 = 64 * kt; n0 = 64 * nt; nvalid = 64;
                    const int isup = n0 >= FFN, u0 = n0 - isup * FFN; dst = (h16*)(ws + WS_WGU + l * WGU_STRIDE); ldd = D; dr0 = 256 * (u0 >> 7) + 128 * isup + (u0 & 127); dk0 = k0; }
                else if ((t -= 1408) < 704) { const int kt = t >> 4, nt = t & 15; src = a.in[22] + (size_t)l * FFN * D; ld = D; k0 = 64 * kt; n0 = 64 * nt; nvalid = 64; dst = (h16*)(ws + WS_WDN + l * WDN_STRIDE); ldd = FFN; dr0 = n0; dk0 = k0; }
                else { t -= 704; const int gate = t / 6, g = t - gate * 6; src = a.in[gate ? 16 : 14] + (size_t)l * 6 * 4096 + g * 4096; ld = 64; k0 = 0; n0 = 0; nvalid = 64;
                    dst = (h16*)(ws + WS_LRUW) + (size_t)((l * 2 + gate) * 6 + g) * 4096; ldd = 64; dr0 = 0; dk0 = 0; }
            }
            xpose_tile(src, ld, k0, n0, nvalid, dst, ldd, dr0, dk0, scr, lane, active);
        }
    }
    __syncthreads();
    {
        LAS float* cact = (LAS float*)lds;
        LAS float* red = (LAS float*)(lds + 65536);
        const float* c = a.in[1];
        for (int idx = tid; idx < NB * D; idx += NTHREADS) { const int b = idx >> 10, k = idx & 1023; cact[k * 16 + b] = siluf(c[idx]); }
        __syncthreads();
        float* modv = (float*)(ws + WS_MOD); float* fmod = (float*)(ws + WS_FMOD);
        for (int item = bid_opaque(); item < 416; item += gdim_opaque()) {
            const float* W; const float* bias; float* outp; int ldw, n0;
            if (item < 384) { const int l = item / 96; n0 = (item - l * 96) * 64; W = a.in[3] + (size_t)l * D * 6144; ldw = 6144; bias = a.in[4] + l * 6144; outp = modv + (size_t)l * 16 * 6144; }
            else { n0 = (item - 384) * 64; W = a.in[24]; ldw = 2048; bias = a.in[25]; outp = fmod; }
            float acc[16];
#pragma unroll
            for (int b = 0; b < 16; ++b) acc[b] = 0.f;
            for (int kk0 = 0; kk0 < 128; kk0 += 16) { float wv[16];
#pragma unroll
                for (int u = 0; u < 16; ++u) wv[u] = W[(size_t)(wave * 128 + kk0 + u) * ldw + n0 + lane];
#pragma unroll
                for (int u = 0; u < 16; ++u) { const int k = wave * 128 + kk0 + u; const float w = wv[u];
#pragma unroll
                    for (int q = 0; q < 4; ++q) { const f32x4 cv = *(const LAS f32x4*)(cact + k * 16 + 4 * q);
                        acc[4 * q + 0] += cv[0] * w; acc[4 * q + 1] += cv[1] * w; acc[4 * q + 2] += cv[2] * w; acc[4 * q + 3] += cv[3] * w; } } }
#pragma unroll
            for (int b = 0; b < 16; ++b) red[(wave * 16 + b) * 64 + lane] = acc[b];
            __syncthreads();
            for (int o = tid; o < 1024; o += NTHREADS) { const int b = o >> 6, j = o & 63; float s = 0.f;
#pragma unroll
                for (int w = 0; w < 8; ++w) s += red[(w * 16 + b) * 64 + j];
                outp[(size_t)b * ldw + n0 + j] = s + bias[n0 + j]; }
            __syncthreads();
        }
    }
    {
        f32x4* r = (f32x4*)(ws + WS_RSS);
        for (int idx = bid_opaque() * NTHREADS + tid; idx < 9 * T / 4; idx += gdim_opaque() * NTHREADS) r[idx] = (f32x4){0.f, 0.f, 0.f, 0.f};
    }
    {
        f32x2* cs = (f32x2*)(ws + WS_CS); const int* pos = (const int*)a.in[2];
        for (int idx = bid_opaque() * NTHREADS + tid; idx < T * 16; idx += gdim_opaque() * NTHREADS) {
            const int tok = idx >> 4, j = idx & 15;
            const float inv = powf(10000.0f, -(float)j * 0.0625f);
            const float ang = (float)pos[tok] * inv;
            f32x2 r; r[0] = cosf(ang); r[1] = sinf(ang); cs[idx] = r;
        }
    }
}

DI void p0b_phase(const Args& a, LAS unsigned char* lds, const int WID_) {
    const int tid = tid_opaque(WID_), lane = tid & 63, wave = tid >> 6;
    unsigned char* ws = a.ws;
    const float* modv = (const float*)(ws + WS_MOD);
    {
        const float* x = a.in[0]; h16* XH = (h16*)(ws + WS_XH); h16* XG = (h16*)(ws + WS_H); float* rss = (float*)(ws + WS_RSS);
        const float* gain = a.in[5];
        for (int row = bid_opaque() * 8 + wave; row < T; row += gdim_opaque() * 8) {
            const int b = row >> 11; float ss = 0.f;
#pragma unroll
            for (int i = 0; i < 2; ++i) { const int col = i * 512 + lane * 8; half8 w, wg;
#pragma unroll
                for (int q = 0; q < 2; ++q) { const f32x4 v = *(const f32x4*)(x + (size_t)row * D + col + 4 * q), g = *(const f32x4*)(gain + col + 4 * q), sc = *(const f32x4*)(modv + (size_t)b * 6144 + 1 * D + col + 4 * q);
#pragma unroll
                    for (int j = 0; j < 4; ++j) { const h16 hn = (h16)v[j]; const float xr = (float)hn; w[4 * q + j] = hn; ss += xr * xr; wg[4 * q + j] = (h16)(xr * g[j] * (1.0f + sc[j])); } }
                *(half8*)(XH + (size_t)row * D + col) = w; *(half8*)(XG + (size_t)row * D + col) = wg; }
            ss = wave_sum(ss, lane);
            if (lane == 0) rss[row] = ss;
        }
    }
    __syncthreads();
    {
        LAS float* shl = (LAS float*)lds;
        LAS float* red = (LAS float*)(lds + 65536);
        for (int item = bid_opaque(); item < 4 * 119; item += gdim_opaque()) {
            const int l = item / 119, it = item - l * 119;
            const float* W; float* outp; int ldw, n0, nmax, ldo, shoff;
            if (it < 31) { n0 = it * 64; W = a.in[6] + (size_t)l * D * DIN; ldw = DIN; nmax = DIN; outp = (float*)(ws + WS_B1) + (size_t)l * 16 * DINP; ldo = DINP; shoff = 0; }
            else { n0 = (it - 31) * 64; W = a.in[21] + (size_t)l * D * 2 * FFN; ldw = 2 * FFN; nmax = 2 * FFN; outp = (float*)(ws + WS_B2) + (size_t)l * 16 * 2 * FFN; ldo = 2 * FFN; shoff = 3 * D; }
            const float* modl = modv + (size_t)l * 16 * 6144;
            for (int idx = tid; idx < NB * D; idx += NTHREADS) { const int b = idx >> 10, k = idx & 1023; shl[k * 16 + b] = modl[(size_t)b * 6144 + shoff + k]; }
            __syncthreads();
            const bool colok = (n0 + lane) < nmax;
            float acc[16];
#pragma unroll
            for (int b = 0; b < 16; ++b) acc[b] = 0.f;
            for (int kk0 = 0; kk0 < 128; kk0 += 16) { float wv[16];
#pragma unroll
                for (int u = 0; u < 16; ++u) wv[u] = colok ? W[(size_t)(wave * 128 + kk0 + u) * ldw + n0 + lane] : 0.f;
#pragma unroll
                for (int u = 0; u < 16; ++u) { const int k = wave * 128 + kk0 + u; const float w = wv[u];
#pragma unroll
                    for (int q = 0; q < 4; ++q) { const f32x4 cv = *(const LAS f32x4*)(shl + k * 16 + 4 * q);
                        acc[4 * q + 0] += cv[0] * w; acc[4 * q + 1] += cv[1] * w; acc[4 * q + 2] += cv[2] * w; acc[4 * q + 3] += cv[3] * w; } } }
#pragma unroll
            for (int b = 0; b < 16; ++b) red[(wave * 16 + b) * 64 + lane] = acc[b];
            __syncthreads();
            for (int o = tid; o < 1024; o += NTHREADS) { const int b = o >> 6, j = o & 63; float sm = 0.f;
#pragma unroll
                for (int w = 0; w < 8; ++w) sm += red[(w * 16 + b) * 64 + j];
                outp[(size_t)b * ldo + n0 + j] = sm; }
            __syncthreads();
        }
    }
}

DI void final_phase(const Args& a, const int WID_) {
    const int tid = tid_opaque(WID_), lane = tid & 63, wave = tid >> 6;
    unsigned char* ws = a.ws;
    const h16* XH = (const h16*)(ws + WS_XH); const float* rss = (const float*)(ws + WS_RSS) + (size_t)8 * T; const float* fmod = (const float*)(ws + WS_FMOD);
    const float* gain = a.in[23]; float* out = a.out;
    for (int row = bid_opaque() * 8 + wave; row < T; row += gdim_opaque() * 8) {
        const int b = row >> 11; const float rstd = rsqrtf(rss[row] * (1.0f / D) + EPS);
#pragma unroll
        for (int i = 0; i < 2; ++i) { const int col = i * 512 + lane * 8; const half8 v = *(const half8*)(XH + (size_t)row * D + col);
#pragma unroll
            for (int q = 0; q < 2; ++q) { const f32x4 g = *(const f32x4*)(gain + col + 4 * q), sc = *(const f32x4*)(fmod + (size_t)b * 2048 + D + col + 4 * q), sh = *(const f32x4*)(fmod + (size_t)b * 2048 + col + 4 * q); f32x4 y;
#pragma unroll
                for (int j = 0; j < 4; ++j) y[j] = (float)v[4 * q + j] * rstd * g[j] * (1.0f + sc[j]) + sh[j];
                *(f32x4*)(out + (size_t)row * D + col + 4 * q) = y; } }
    }
}

DI void prep_phase(const Args& a, int l, const int WID_) {
    const int tid = tid_opaque(WID_), lane = tid & 63, wave = tid >> 6;
    unsigned char* ws = a.ws;
    const h16* Z = (const h16*)(ws + WS_Z); h16* CQKV = (h16*)(ws + WS_CQKV); h16* KR = (h16*)(ws + WS_KR); h16* RQ = (h16*)(ws + WS_RQ); h16* RK = (h16*)(ws + WS_RK);
    const f32x2* cs = (const f32x2*)(ws + WS_CS);
    const float* qn = a.in[7] + l * 256; const float* kvn = a.in[9] + l * 128;
    const f32x4 qg = *(const f32x4*)(qn + 4 * lane); const f32x2 kg = *(const f32x2*)(kvn + 2 * lane);
    const int hh = lane >> 4, j = lane & 15;
    for (int tok = bid_opaque() * 8 + wave; tok < T; tok += gdim_opaque() * 8) {
        const h16* zr = Z + (size_t)tok * DINP; const int b = tok >> 11, s = tok & 2047;
        const half4 cq = *(const half4*)(zr + C_CQ + 4 * lane); const half2v ck = *(const half2v*)(zr + C_CKV + 2 * lane);
        const float kr1 = (float)zr[C_KR + j], kr2 = (float)zr[C_KR + 16 + j];
        const float q1 = (float)zr[C_RQ + 32 * hh + j], q2 = (float)zr[C_RQ + 32 * hh + 16 + j];
        const float k1 = (float)zr[C_RK + 32 * hh + j], k2 = (float)zr[C_RK + 32 * hh + 16 + j];
        const f32x2 c = cs[(size_t)tok * 16 + j];
        float f0 = (float)cq[0], f1 = (float)cq[1], f2 = (float)cq[2], f3 = (float)cq[3];
        float ssq = wave_sum(f0 * f0 + f1 * f1 + f2 * f2 + f3 * f3, lane);
        const float rq = rsqrtf(ssq * (1.0f / 256.0f) + EPS);
        half4 oq; oq[0] = (h16)(f0 * rq * qg[0]); oq[1] = (h16)(f1 * rq * qg[1]); oq[2] = (h16)(f2 * rq * qg[2]); oq[3] = (h16)(f3 * rq * qg[3]);
        *(half4*)(CQKV + (size_t)tok * KUP + 4 * lane) = oq;
        const float g0 = (float)ck[0], g1 = (float)ck[1];
        float ssk = wave_sum(g0 * g0 + g1 * g1, lane);
        const float rk = rsqrtf(ssk * (1.0f / 128.0f) + EPS);
        half2v ok; ok[0] = (h16)(g0 * rk * kg[0]); ok[1] = (h16)(g1 * rk * kg[1]);
        *(half2v*)(CQKV + (size_t)tok * KUP + 256 + 2 * lane) = ok;
        if (hh == 0) { h16* d0 = KR + (size_t)tok * 32; d0[j] = (h16)(kr1 * c[0] - kr2 * c[1]); d0[16 + j] = (h16)(kr1 * c[1] + kr2 * c[0]); }
        { h16* dq = RQ + ((size_t)(b * 4 + hh) * SEQ + s) * 32; dq[j] = (h16)(q1 * c[0] - q2 * c[1]); dq[16 + j] = (h16)(q1 * c[1] + q2 * c[0]);
          const float ks = 0.17677669529663687f;
          h16* dk = RK + ((size_t)(b * 4 + hh) * SEQ + s) * 32; dk[j] = (h16)((k1 * c[0] - k2 * c[1]) * ks); dk[16 + j] = (h16)((k1 * c[1] + k2 * c[0]) * ks); }
    }
}

template <bool RET>
DI void attn_unit(const Args& a, int l, int b, int h, int qb, LAS unsigned char* lds, const int WID_) {
    constexpr int DK = RET ? 32 : 96, KS = DK / 16, KSTR = RET ? 80 : 208, VSTR = 192, CPR = DK / 8;
    constexpr int TK = 128;
    constexpr int KBUF = TK * 208, VOFF = 2 * KBUF, VBUF = TK * VSTR, NKC = RET ? 1 : 3;
    const int tid = tid_opaque(WID_), lane = tid & 63, wave = WID_, l32 = lane & 31, hi = lane >> 5;
    unsigned char* ws = a.ws;
    const h16* UPb = (const h16*)(ws + WS_UP) + (size_t)b * SEQ * NUP;
    const h16* Qp = RET ? (const h16*)(ws + WS_RQ) + (size_t)(b * 4 + h) * SEQ * 32 : UPb + 96 * h;
    const h16* Kp = RET ? (const h16*)(ws + WS_RK) + (size_t)(b * 4 + h) * SEQ * 32 : UPb + 576 + 128 * h;
    const h16* KRp = (const h16*)(ws + WS_KR) + (size_t)b * SEQ * 32;
    const h16* Vp = RET ? (const h16*)(ws + WS_Z) + (size_t)b * SEQ * DINP + C_RV + 64 * h : UPb + 576 + 128 * h + 64;
    constexpr int vld = RET ? DINP : NUP, qld = RET ? 32 : NUP, kld = RET ? 32 : NUP;
    constexpr float QS = 0.10206207261596577f * 1.4426950408889634f;
    const int qrow = 256 * qb + 32 * wave + l32;
    const int qmax_w = 256 * qb + 32 * wave + 31, qmin_w = 256 * qb + 32 * wave;
    half8 qf[KS];
#pragma unroll
    for (int s = 0; s < KS; ++s) qf[s] = *(const half8*)(Qp + (size_t)qrow * qld + 16 * s + 8 * hi);
    if (!RET) {
        const f32x2* csp = (const f32x2*)(ws + WS_CS) + (size_t)(b * SEQ + qrow) * 16 + 8 * hi;
#pragma unroll
        for (int e = 0; e < 8; ++e) { const f32x2 c = csp[e]; const float x1 = (float)qf[KS - 2][e], x2 = (float)qf[KS - 1][e];
            qf[KS - 2][e] = (h16)(x1 * c[0] - x2 * c[1]); qf[KS - 1][e] = (h16)(x1 * c[1] + x2 * c[0]); }
    }
    f32x16 oacc[2];
#pragma unroll
    for (int i = 0; i < 16; ++i) { oacc[0][i] = 0.f; oacc[1][i] = 0.f; }
    float m_run = -INFINITY, l_run = 0.f;
    const float lg = RET ? log2f(1.0f - exp2f(-5.0f - (float)h)) : 0.f;
    float Bc[RET ? 2 : 1][RET ? 16 : 1];
    if (RET) {
#pragma unroll
        for (int mt = 0; mt < 2; ++mt)
#pragma unroll
            for (int i = 0; i < 16; ++i) Bc[mt][i] = __builtin_amdgcn_exp2f(-lg * (float)(32 * mt + crow(i, hi)));
    }
    int krow[NKC], kcc[NKC];
#pragma unroll
    for (int i = 0; i < NKC; ++i) { const int c = tid + 512 * i; krow[i] = c / CPR; kcc[i] = c - krow[i] * CPR; }
    const int vcc = tid & 7;
    const int nkt2 = 2 * (qb + 1);
    half8 kreg[NKC], vreg[2];
    auto gload = [&](int kt2) {
#pragma unroll
        for (int i = 0; i < NKC; ++i) kreg[i] = (RET || kcc[i] < 8) ? *(const half8*)(Kp + (size_t)(TK * kt2 + krow[i]) * kld + kcc[i] * 8) : *(const half8*)(KRp + (size_t)(TK * kt2 + krow[i]) * 32 + (kcc[i] - 8) * 8);
#pragma unroll
        for (int i = 0; i < 2; ++i) vreg[i] = *(const half8*)(Vp + (size_t)(TK * kt2 + (tid >> 3) + 64 * i) * vld + vcc * 8);
    };
    gload(0);
    const int li = lane & 15, q4 = li >> 2, p4 = li & 3, g1 = (lane >> 4) & 1;
    auto compute = [&](const int kt, LAS unsigned char* Kt, LAS unsigned char* Vt) {
        if (64 * kt <= qmax_w) {
            f32x16 sv[2];
#pragma unroll
            for (int i = 0; i < 16; ++i) { sv[0][i] = 0.f; sv[1][i] = 0.f; }
#pragma unroll
            for (int s = 0; s < KS; ++s) {
                const half8 kf0 = *(const LAS half8*)(Kt + l32 * KSTR + (16 * s + 8 * hi) * 2);
                const half8 kf1 = *(const LAS half8*)(Kt + (32 + l32) * KSTR + (16 * s + 8 * hi) * 2);
                sv[0] = __builtin_amdgcn_mfma_f32_32x32x16_f16(kf0, qf[s], sv[0], 0, 0, 0);
                sv[1] = __builtin_amdgcn_mfma_f32_32x32x16_f16(kf1, qf[s], sv[1], 0, 0, 0);
            }
            half8 vfr[2][2][2];
#pragma unroll
            for (int mt = 0; mt < 2; ++mt)
#pragma unroll
                for (int sp = 0; sp < 2; ++sp) {
                    const int krw = 32 * mt + 16 * sp + 4 * hi + q4;
#pragma unroll
                    for (int mtv = 0; mtv < 2; ++mtv) {
                        LAS unsigned char* ap = Vt + krw * VSTR + (32 * mtv + 16 * g1 + 4 * p4) * 2;
                        const s16x4 t0 = __builtin_amdgcn_ds_read_tr16_b64_v4i16((LAS s16x4*)ap);
                        const s16x4 t1 = __builtin_amdgcn_ds_read_tr16_b64_v4i16((LAS s16x4*)(ap + 8 * VSTR));
                        const half4 h0 = __builtin_bit_cast(half4, t0), h1 = __builtin_bit_cast(half4, t1);
                        half8 vf; vf[0] = h0[0]; vf[1] = h0[1]; vf[2] = h0[2]; vf[3] = h0[3]; vf[4] = h1[0]; vf[5] = h1[1]; vf[6] = h1[2]; vf[7] = h1[3];
                        vfr[mt][sp][mtv] = vf;
                    }
                }
            __builtin_amdgcn_sched_barrier(0);
            const bool need_mask = (64 * kt + 63 > qmin_w);
            half8 pf[2][2];
            if (!RET) {
                if (need_mask) {
#pragma unroll
                    for (int mt = 0; mt < 2; ++mt)
#pragma unroll
                        for (int i = 0; i < 16; ++i) { const int key = 64 * kt + 32 * mt + crow(i, hi); if (key > qrow) sv[mt][i] = -INFINITY; }
                }
                float mx = sv[0][0];
#pragma unroll
                for (int i = 1; i < 16; ++i) mx = fmaxf(mx, sv[0][i]);
#pragma unroll
                for (int i = 0; i < 16; ++i) mx = fmaxf(mx, sv[1][i]);
                mx = fmaxf(mx, shfl_xor_f(mx, 32, lane));
                constexpr float THR = 6.0f;
                const float pm = mx * QS;
                if (__builtin_amdgcn_ballot_w64((pm - m_run) > THR) != 0ull) {
                    asm volatile("" ::: "memory");
                    const float m_new = fmaxf(m_run, pm);
                    const float alpha = __builtin_amdgcn_exp2f(m_run - m_new);
                    m_run = m_new; l_run *= alpha;
#pragma unroll
                    for (int i = 0; i < 16; ++i) { oacc[0][i] *= alpha; oacc[1][i] *= alpha; }
                }
                f32x2 ps2 = {0.f, 0.f};
#pragma unroll
                for (int mt = 0; mt < 2; ++mt)
#pragma unroll
                    for (int i = 0; i < 16; i += 2) { const f32x2 t = (f32x2){sv[mt][i], sv[mt][i + 1]} * QS - m_run;
                        f32x2 pp; pp[0] = __builtin_amdgcn_exp2f(t[0]); pp[1] = __builtin_amdgcn_exp2f(t[1]); ps2 += pp;
                        pf[mt][i >> 3][i & 7] = (h16)pp[0]; pf[mt][i >> 3][(i & 7) + 1] = (h16)pp[1]; }
                l_run += ps2[0] + ps2[1];
            } else {
                const float Aq = __builtin_amdgcn_exp2f(lg * (float)(qrow - 64 * kt));
                if (need_mask) {
#pragma unroll
                    for (int mt = 0; mt < 2; ++mt)
#pragma unroll
                        for (int i = 0; i < 16; ++i) { const int key = 64 * kt + 32 * mt + crow(i, hi); if (key > qrow) sv[mt][i] = 0.f; }
                }
#pragma unroll
                for (int mt = 0; mt < 2; ++mt)
#pragma unroll
                    for (int i = 0; i < 16; ++i) pf[mt][i >> 3][i & 7] = (h16)(sv[mt][i] * (Aq * Bc[RET ? mt : 0][RET ? i : 0]));
            }
#pragma unroll
            for (int mt = 0; mt < 2; ++mt)
#pragma unroll
                for (int sp = 0; sp < 2; ++sp)
#pragma unroll
                    for (int mtv = 0; mtv < 2; ++mtv) oacc[mtv] = __builtin_amdgcn_mfma_f32_32x32x16_f16(vfr[mt][sp][mtv], pf[mt][sp], oacc[mtv], 0, 0, 0);
        }
    };
    for (int kt2 = 0; kt2 < nkt2; ++kt2) {
        const int buf = kt2 & 1;
        LAS unsigned char* Kt = lds + buf * KBUF; LAS unsigned char* Vt = lds + VOFF + buf * VBUF;
#pragma unroll
        for (int i = 0; i < NKC; ++i) *(LAS half8*)(Kt + krow[i] * KSTR + kcc[i] * 16) = kreg[i];
#pragma unroll
        for (int i = 0; i < 2; ++i) *(LAS half8*)(Vt + ((tid >> 3) + 64 * i) * VSTR + vcc * 16) = vreg[i];
        __syncthreads();
        gload(kt2 + 1 < nkt2 ? kt2 + 1 : kt2);
        compute(2 * kt2, Kt, Vt);
        compute(2 * kt2 + 1, Kt + 64 * KSTR, Vt + 64 * VSTR);
    }
    h16* Y = (h16*)(ws + WS_H) + (size_t)(b * SEQ + qrow) * D;
    if (!RET) {
        const float lt = l_run + shfl_xor_f(l_run, 32, lane); const float inv = 1.0f / lt;
#pragma unroll
        for (int mtv = 0; mtv < 2; ++mtv)
#pragma unroll
            for (int i4 = 0; i4 < 4; ++i4) { half4 w;
#pragma unroll
                for (int j = 0; j < 4; ++j) w[j] = (h16)(oacc[mtv][4 * i4 + j] * inv);
                *(half4*)(Y + h * 64 + 32 * mtv + 8 * i4 + 4 * hi) = w; }
    } else {
        float s1 = 0.f;
#pragma unroll
        for (int i = 0; i < 16; ++i) s1 += oacc[0][i] + oacc[1][i];
        s1 += shfl_xor_f(s1, 32, lane);
        const float mu = s1 * (1.0f / 64.0f);
        float s2 = 0.f;
#pragma unroll
        for (int i = 0; i < 16; ++i) { const float d0 = oacc[0][i] - mu, d1 = oacc[1][i] - mu; s2 += d0 * d0 + d1 * d1; }
        s2 += shfl_xor_f(s2, 32, lane);
        const float rstd = rsqrtf(s2 * (1.0f / 64.0f) + EPS);
        const float* gn = a.in[11] + l * 256 + h * 64;
        const h16* gp = (const h16*)(ws + WS_Z) + (size_t)(b * SEQ + qrow) * DINP + C_RG + h * 64;
#pragma unroll
        for (int mtv = 0; mtv < 2; ++mtv)
#pragma unroll
            for (int i4 = 0; i4 < 4; ++i4) { const int dv = 32 * mtv + 8 * i4 + 4 * hi;
                const half4 gg = *(const half4*)(gp + dv); const f32x4 gnv = *(const f32x4*)(gn + dv); half4 w;
#pragma unroll
                for (int j = 0; j < 4; ++j) w[j] = (h16)(siluf((float)gg[j]) * (oacc[mtv][4 * i4 + j] - mu) * rstd * gnv[j]);
                *(half4*)(Y + 384 + h * 64 + dv) = w; }
    }
}

DI float gelu_tanh(float x) { const float u = 0.7978845608028654f * (x + 0.044715f * x * x * x); const float t = 1.0f - 2.0f * __builtin_amdgcn_rcpf(1.0f + __expf(2.0f * u)); return 0.5f * x * (1.0f + t); }
DI float sigmoidf_(float v) { return __builtin_amdgcn_rcpf(1.0f + __expf(-v)); }
DI float neg_expm1(float x) { const float big = 1.0f - __expf(x); const float sm = -x * (1.0f + x * (0.5f + x * (0.16666667f + x * 0.041666668f))); return (x > -0.1f) ? sm : big; }
DI void lru_unit(const Args& a, int l, int b, int g, LAS unsigned char* lds, const int WID_) {
    const int tid = tid_opaque(WID_), lane = tid & 63, wave = WID_, l32 = lane & 31, hi = lane >> 5;
    unsigned char* ws = a.ws;
    const h16* Z = (const h16*)(ws + WS_Z) + (size_t)b * SEQ * DINP;
    h16* Y = (h16*)(ws + WS_H) + (size_t)b * SEQ * D + 640 + 64 * g + lane;
    const int ch = 64 * g + lane;
    const float cw0 = a.in[12][(l * 4 + 0) * 384 + ch], cw1 = a.in[12][(l * 4 + 1) * 384 + ch], cw2 = a.in[12][(l * 4 + 2) * 384 + ch], cw3 = a.in[12][(l * 4 + 3) * 384 + ch];
    const float cb = a.in[13][l * 384 + ch], ba = a.in[15][l * 384 + ch], bi = a.in[17][l * 384 + ch];
    const float lam = a.in[18][l * 384 + ch];
    const float sp8 = 8.0f * log1pf(expf(-lam));
    const h16* WA = (const h16*)(ws + WS_LRUW) + (size_t)((l * 2 + 0) * 6 + g) * 4096;
    const h16* WI = (const h16*)(ws + WS_LRUW) + (size_t)((l * 2 + 1) * 6 + g) * 4096;
    LAS unsigned char* reg = lds + wave * 16384;
    LAS float* Rb = (LAS float*)reg; LAS float* Ib = (LAS float*)(reg + 8192);
    LAS float* cA = (LAS float*)(lds + 131072); LAS float* cH = (LAS float*)(lds + 131072 + 2048);
    float h_round = 0.f;
    for (int rd = 0; rd < 8; ++rd) {
        const int t0 = rd * 256 + wave * 32;
        h16 gvh[32];
        {
            const h16* ug = Z + C_UG + ch;
#pragma unroll
            for (int t = 0; t < 32; ++t) gvh[t] = ug[(size_t)(t0 + t) * DINP];
        }
        half8 wfa[2][4], wfi[2][4];
#pragma unroll
        for (int nt = 0; nt < 2; ++nt)
#pragma unroll
            for (int s = 0; s < 4; ++s) { wfa[nt][s] = *(const half8*)(WA + (32 * nt + l32) * 64 + 16 * s + 8 * hi); wfi[nt][s] = *(const half8*)(WI + (32 * nt + l32) * 64 + 16 * s + 8 * hi); }
        float xc[32];
        {
            const h16* ux = Z + C_UX + ch;
            float xm3 = 0.f, xm2 = 0.f, xm1 = 0.f;
            if (t0 > 0) { xm3 = (float)ux[(size_t)(t0 - 3) * DINP]; xm2 = (float)ux[(size_t)(t0 - 2) * DINP]; xm1 = (float)ux[(size_t)(t0 - 1) * DINP]; }
            float xv[32];
#pragma unroll
            for (int t = 0; t < 32; ++t) xv[t] = (float)ux[(size_t)(t0 + t) * DINP];
#pragma unroll
            for (int t = 0; t < 32; ++t) { const float v = cb + cw0 * xm3 + cw1 * xm2 + cw2 * xm1 + cw3 * xv[t]; xc[t] = v; xm3 = xm2; xm2 = xm1; xm1 = xv[t];
                *(LAS h16*)(reg + t * 144 + lane * 2) = (h16)v; }
        }
        __syncthreads();
        {
            half8 xa[4];
#pragma unroll
            for (int s = 0; s < 4; ++s) xa[s] = *(const LAS half8*)(reg + l32 * 144 + (16 * s + 8 * hi) * 2);
            f32x16 ra[2], ia[2];
#pragma unroll
            for (int nt = 0; nt < 2; ++nt) {
#pragma unroll
                for (int i = 0; i < 16; ++i) { ra[nt][i] = 0.f; ia[nt][i] = 0.f; }
#pragma unroll
                for (int s = 0; s < 4; ++s) { ra[nt] = __builtin_amdgcn_mfma_f32_32x32x16_f16(xa[s], wfa[nt][s], ra[nt], 0, 0, 0); ia[nt] = __builtin_amdgcn_mfma_f32_32x32x16_f16(xa[s], wfi[nt][s], ia[nt], 0, 0, 0); }
            }
            __syncthreads();
#pragma unroll
            for (int nt = 0; nt < 2; ++nt)
#pragma unroll
                for (int i = 0; i < 16; ++i) { const int t = crow(i, hi); Rb[t * 64 + 32 * nt + l32] = ra[nt][i]; Ib[t * 64 + 32 * nt + l32] = ia[nt][i]; }
        }
        __syncthreads();
        float Ac = 1.f, hl = 0.f;
#pragma unroll
        for (int t = 0; t < 32; ++t) {
            const float ea = 1.0f + __expf(-(Rb[t * 64 + lane] + ba)), ei = 1.0f + __expf(-(Ib[t * 64 + lane] + bi));
            const float rc = __builtin_amdgcn_rcpf(ea * ei);
            const float r = ei * rc, ig = ea * rc;
            const float log_a = -sp8 * r;
            const float av = __expf(log_a);
            const float bv = __builtin_amdgcn_sqrtf(neg_expm1(2.0f * log_a)) * ig * xc[t];
            hl = av * hl + bv; Ac = Ac * av;
            Rb[t * 64 + lane] = Ac; Ib[t * 64 + lane] = hl;
        }
        cA[wave * 64 + lane] = Ac; cH[wave * 64 + lane] = hl;
        __syncthreads();
        float h_in = 0.f, hc = h_round;
#pragma unroll
        for (int w = 0; w < 8; ++w) { if (w == wave) h_in = hc; hc = cA[w * 64 + lane] * hc + cH[w * 64 + lane]; }
        h_round = hc;
        {
#pragma unroll
            for (int t = 0; t < 32; ++t) { const float hv = Ib[t * 64 + lane] + Rb[t * 64 + lane] * h_in; Y[(size_t)(t0 + t) * D] = (h16)(gelu_tanh((float)gvh[t]) * hv); }
        }
        __syncthreads();
    }
}

DI void mixer_phase(const Args& a, int lc, LAS unsigned char* lds, const int WID_) {
    const int l = lc & 3;
    unsigned* ctr = (unsigned*)(a.ws + WS_CTL) + 64 * lc;
    LAS unsigned* su = (LAS unsigned*)(lds + LDS_BYTES - 64);
    constexpr int NLRU = (PROBE_MODE == 6) ? 192 : 96;
    constexpr int NMLA = (PROBE_MODE == 7) ? 192 : 96, NRET = (PROBE_MODE == 8) ? 128 : 64, NSLOT = NMLA + NRET;
    constexpr int NUNITS = NLRU + 8 * NSLOT;
    for (;;) {
        if (tid_opaque(WID_) == 0) *su = atomicAdd(ctr, 1u);
        __syncthreads();
        const int u = (int)*su;
        __syncthreads();
        if (u >= NUNITS) break;
        if (u < NLRU) { const int uu = u % 96; lru_unit(a, l, uu / 6, uu % 6, lds, WID_); }
        else { const int v = u - NLRU, qs = v / NSLOT, w = v - qs * NSLOT, qb = 7 - qs;
            if (w < NMLA) { const int ww = w % 96; attn_unit<false>(a, l, ww / 6, ww % 6, qb, lds, WID_); }
            else { const int r = (w - NMLA) % 64; attn_unit<true>(a, l, r >> 2, r & 3, qb, lds, WID_); } }
        __syncthreads();
    }
}

DI void grid_bar(unsigned* ctr, unsigned target, const int WID_) {
    asm volatile("s_waitcnt vmcnt(0) lgkmcnt(0)" ::: "memory");
    __syncthreads();
    if (tid_opaque(WID_) == 0) {
        __builtin_amdgcn_fence(__ATOMIC_RELEASE, "agent");
        asm volatile("s_waitcnt vmcnt(0)" ::: "memory");
        (void)__hip_atomic_fetch_add(ctr, 1u, __ATOMIC_RELAXED, __HIP_MEMORY_SCOPE_AGENT);
        while (__hip_atomic_load(ctr, __ATOMIC_RELAXED, __HIP_MEMORY_SCOPE_AGENT) < target) __builtin_amdgcn_s_sleep(1);
        __builtin_amdgcn_fence(__ATOMIC_ACQUIRE, "agent");
        asm volatile("s_waitcnt vmcnt(0)" ::: "memory");
    }
    __syncthreads();
}

DI void grid_bar2(unsigned* ctl, unsigned k, unsigned x, unsigned nx, unsigned nxcd, const int WID_) {
    asm volatile("s_waitcnt vmcnt(0) lgkmcnt(0)" ::: "memory");
    __syncthreads();
    if (tid_opaque(WID_) == 0) {
        unsigned* A = ctl + 520 + 16 * x; unsigned* GC = ctl + 656; unsigned* R = ctl + 704 + 16 * x;
        const unsigned old = __hip_atomic_fetch_add(A, 1u, __ATOMIC_RELAXED, __HIP_MEMORY_SCOPE_AGENT);
        unsigned sp = 0;
        if (old + 1u == k * nx) {
            __builtin_amdgcn_fence(__ATOMIC_RELEASE, "agent");
            asm volatile("s_waitcnt vmcnt(0)" ::: "memory");
            (void)__hip_atomic_fetch_add(GC, 1u, __ATOMIC_RELAXED, __HIP_MEMORY_SCOPE_AGENT);
            while (__hip_atomic_load(GC, __ATOMIC_RELAXED, __HIP_MEMORY_SCOPE_AGENT) < k * nxcd) { __builtin_amdgcn_s_sleep(1); if (++sp > (1u << 22)) break; }
            __hip_atomic_store(R, k, __ATOMIC_RELAXED, __HIP_MEMORY_SCOPE_AGENT);
        } else {
            while (__hip_atomic_load(R, __ATOMIC_RELAXED, __HIP_MEMORY_SCOPE_AGENT) < k) { __builtin_amdgcn_s_sleep(1); if (++sp > (1u << 22)) break; }
        }
        __builtin_amdgcn_fence(__ATOMIC_ACQUIRE, "agent");
        asm volatile("s_waitcnt vmcnt(0)" ::: "memory");
    }
    __syncthreads();
}

__global__ void __launch_bounds__(NTHREADS, 2) hymba_fwd(Args a_unused) {
    extern __shared__ __attribute__((aligned(16))) unsigned char lds_raw[];
    LAS unsigned char* lds = (LAS unsigned char*)lds_raw;
    cg::grid_group grid = cg::this_grid();
    const int WID_ = __builtin_amdgcn_readfirstlane((int)(threadIdx.x >> 6));
    int l = 0, nbar = 0;
    const unsigned XCC_ = (unsigned)__builtin_amdgcn_s_getreg((3 << 11) | 20) & 7u;
    if (threadIdx.x == 0) (void)__hip_atomic_fetch_add((unsigned*)(args_opaque()->ws + WS_CTL) + 832 + 16 * XCC_, 1u, __ATOMIC_RELAXED, __HIP_MEMORY_SCOPE_AGENT);
    unsigned NX_ = 0, NXCD_ = 0;
#define PHASE_BEGIN(KIND) { const int nrep = (PROBE_MODE != 0 && PROBE_MODE == (KIND)) ? 2 : 1; for (int rep = 0; rep < nrep; ++rep) { const ArgsP ap = args_opaque(); const int BID = bid_opaque(), G = gdim_opaque(); (void)BID; (void)G; const Args a = load_args(ap); unsigned char* ws = a.ws; const float* modv = (const float*)(ws + WS_MOD); const float* modl = modv + (size_t)l * 16 * 6144; h16* XH = (h16*)(ws + WS_XH); float* RSS = (float*)(ws + WS_RSS); (void)RSS; \
    h16* H = (h16*)(ws + WS_H); h16* Z = (h16*)(ws + WS_Z); h16* HID = (h16*)(ws + WS_HID); (void)modl; (void)XH; (void)H; (void)Z; (void)HID;
#define PHASE_END_(LAST)   if (rep + 1 < nrep || !LAST) { if (gdim_opaque() == 0x7fffffff) grid.sync(); ++nbar; \
        if (nbar == 1) { grid_bar((unsigned*)(args_opaque()->ws + WS_CTL) + 512, (unsigned)gdim_opaque(), WID_); \
            unsigned* cen = (unsigned*)(args_opaque()->ws + WS_CTL) + 832; unsigned nn = 0; \
            for (int xx = 0; xx < 8; ++xx) { const unsigned cv = __hip_atomic_load(cen + 16 * xx, __ATOMIC_RELAXED, __HIP_MEMORY_SCOPE_AGENT); nn += cv ? 1u : 0u; if ((unsigned)xx == XCC_) NX_ = cv; } \
            NX_ = __builtin_amdgcn_readfirstlane(NX_); NXCD_ = __builtin_amdgcn_readfirstlane(nn); } \
        else grid_bar2((unsigned*)(args_opaque()->ws + WS_CTL), (unsigned)(nbar - 1), XCC_, NX_, NXCD_, WID_); } \
    if (PROBE_MODE == 5) { ++nbar; grid_bar2((unsigned*)(args_opaque()->ws + WS_CTL), (unsigned)(nbar - 1), XCC_, NX_, NXCD_, WID_); } } }
#define PHASE_END PHASE_END_(false)

    PHASE_BEGIN(1) p0_prologue(a, lds, WID_); PHASE_END
    PHASE_BEGIN(0) p0b_phase(a, lds, WID_); PHASE_END

    for (l = 0; l < DEPTH; ++l) {
        PHASE_BEGIN(2) { pg8::Gemm g{H, (const h16*)(ws + WS_WIN + l * WIN_STRIDE), T, DINP, D}; pg8::StaticOrder S; S.init(T, DINP, G, BID, D);
            EpiZ E{Z, DINP, RSS + (size_t)(2 * l) * T, (const float*)(ws + WS_B1) + (size_t)l * 16 * DINP, DINP}; pg8::gemm_phase<EpiZ, GEMM_ALIGN, GEMM_SP2>(lds, g, S, E, WID_); } PHASE_END
        PHASE_BEGIN(2) prep_phase(a, l, WID_); PHASE_END
        PHASE_BEGIN(2) { pg8::Gemm g{(const h16*)(ws + WS_CQKV), (const h16*)(ws + WS_WUP + l * WUP_STRIDE), T, NUP, KUP}; pg8::StaticOrder S; S.init(T, NUP, G, BID, KUP, 1);
            EpiF16 E{(h16*)(ws + WS_UP), NUP}; pg8::gemm_phase<EpiF16, GEMM_ALIGN, GEMM_SP2>(lds, g, S, E, WID_); } PHASE_END
        PHASE_BEGIN(3) mixer_phase(a, l + 4 * rep, lds, WID_); PHASE_END
#if PROBE_MODE == 9
        PHASE_BEGIN(0) { pg8::Gemm g{H, (const h16*)(ws + WS_WOUT + l * WOUT_STRIDE), T, D, D}; pg8::StaticOrder S; S.init(T, D, G, BID, D);
            EpiNull E{(float*)(ws + WS_CTL) + 768}; pg8::gemm_phase<EpiNull, GEMM_ALIGN, GEMM_SP2>(lds, g, S, E, WID_); } PHASE_END
#endif
        PHASE_BEGIN(0) { pg8::Gemm g{H, (const h16*)(ws + WS_WOUT + l * WOUT_STRIDE), T, D, D}; pg8::StaticOrder S; S.init(T, D, G, BID, D);
            EpiRes E{XH, modl + 2 * D, 6144, (h16*)(ws + WS_XG2), a.in[20] + l * D, modl + 4 * D, RSS + (size_t)(2 * l + 1) * T}; pg8::gemm_phase<EpiRes, GEMM_ALIGN, GEMM_SP2>(lds, g, S, E, WID_); } PHASE_END
        PHASE_BEGIN(4) { pg8::Gemm g{(const h16*)(ws + WS_XG2), (const h16*)(ws + WS_WGU + l * WGU_STRIDE), T, 2 * FFN, D}; pg8::StaticOrder S; S.init(T, 2 * FFN, G, BID, D);
            EpiSwiGLU E{HID, FFN, RSS + (size_t)(2 * l + 1) * T, (const float*)(ws + WS_B2) + (size_t)l * 16 * 2 * FFN}; pg8::gemm_phase<EpiSwiGLU, GEMM_ALIGN, GEMM_SP2>(lds, g, S, E, WID_); } PHASE_END
#if PROBE_MODE == 10
        PHASE_BEGIN(0) { pg8::Gemm g{HID, (const h16*)(ws + WS_WDN + l * WDN_STRIDE), T, D, FFN}; pg8::StaticOrder S; S.init(T, D, G, BID, FFN);
            EpiNull E{(float*)(ws + WS_CTL) + 768}; pg8::gemm_phase<EpiNull, GEMM_ALIGN, GEMM_SP2>(lds, g, S, E, WID_); } PHASE_END
#endif
        PHASE_BEGIN(0) { pg8::Gemm g{HID, (const h16*)(ws + WS_WDN + l * WDN_STRIDE), T, D, FFN}; pg8::StaticOrder S; S.init(T, D, G, BID, FFN);
            const int ln = (l + 1 < DEPTH) ? l + 1 : l;
            EpiRes E{XH, modl + 5 * D, 6144, (l + 1 < DEPTH) ? H : (h16*)nullptr, a.in[5] + ln * D, modv + (size_t)ln * 16 * 6144 + 1 * D, RSS + (size_t)(2 * l + 2) * T}; pg8::gemm_phase<EpiRes, GEMM_ALIGN, GEMM_SP2>(lds, g, S, E, WID_); } PHASE_END
    }
    PHASE_BEGIN(0) final_phase(a, WID_); PHASE_END_(true)
#undef PHASE_BEGIN
#undef PHASE_END
#undef PHASE_END_
}

extern "C" void kernel_launch(void* const* d_in, const int* in_sizes, int n_in, void* d_out, int out_size, void* d_ws, size_t ws_size, hipStream_t stream) {
    static int grid = 0;
    if (grid == 0) {
        if (n_in != 26 || out_size != T * D || ws_size < WS_END) { fprintf(stderr, "kernel_launch: unexpected shapes (n_in %d out %d ws %zu)\n", n_in, out_size, ws_size); grid = -1; return; }
        int dev = 0, cus = 0, per_cu = 0;
        hipGetDevice(&dev); hipDeviceGetAttribute(&cus, hipDeviceAttributeMultiprocessorCount, dev);
        if (hipFuncSetAttribute((const void*)hymba_fwd, hipFuncAttributeMaxDynamicSharedMemorySize, LDS_BYTES) != hipSuccess) { fprintf(stderr, "kernel_launch: hipFuncSetAttribute failed\n"); grid = -1; return; }
        if (hipOccupancyMaxActiveBlocksPerMultiprocessor(&per_cu, (const void*)hymba_fwd, NTHREADS, LDS_BYTES) != hipSuccess || per_cu < 1) { fprintf(stderr, "kernel_launch: occupancy query gave %d\n", per_cu); per_cu = 1; }
        (void)hipGetLastError();
        grid = cus * 1;
    }
    if (grid < 0) return;
    hipMemsetAsync((char*)d_ws + WS_CTL, 0, CTL_BYTES, stream);
    Args a{};
    for (int i = 0; i < 26; ++i) a.in[i] = (const float*)d_in[i];
    a.out = (float*)d_out; a.ws = (unsigned char*)d_ws; a.ph_lo = 0; a.ph_hi = 1 << 20;
    void* kargs[] = {&a};
    hipError_t e = hipLaunchCooperativeKernel((const void*)hymba_fwd, dim3(grid), dim3(NTHREADS), kargs, LDS_BYTES, stream);
    if (e != hipSuccess) fprintf(stderr, "kernel_launch: cooperative launch failed: %s (grid %d)\n", hipGetErrorString(e), grid);
}
```

```cpp
#include <hip/hip_runtime.h>
#include <hip/hip_cooperative_groups.h>
#include <cstdio>
#include <cstdint>
namespace cg = cooperative_groups;

#define LAS __attribute__((address_space(3)))
#define DI __device__ __forceinline__
typedef _Float16 h16;
typedef _Float16 half8 __attribute__((ext_vector_type(8)));
typedef _Float16 half4 __attribute__((ext_vector_type(4)));
typedef _Float16 half2v __attribute__((ext_vector_type(2)));
typedef short s16x4 __attribute__((ext_vector_type(4)));
typedef float f32x2 __attribute__((ext_vector_type(2)));
typedef float f32x4 __attribute__((ext_vector_type(4)));
typedef float f32x16 __attribute__((ext_vector_type(16)));

constexpr int D = 1024, NB = 16, SEQ = 2048, T = NB * SEQ, DEPTH = 4;
constexpr int DIN = 1952, DINP = 2048, FFN = 2816, NMOD = 6;
constexpr int KUP = 384, NUP = 1536;
constexpr int C_CQ = 0, C_CKV = 256, C_KR = 384, C_RQ = 416, C_RK = 544, C_RV = 672, C_RG = 928, C_UX = 1184, C_UG = 1568;
constexpr float EPS = 1e-6f;

constexpr size_t MiB = 1u << 20;
constexpr size_t WS_CTL = 0, CTL_BYTES = 4096;
constexpr size_t WS_MOD = 1 * MiB;
constexpr size_t WS_FMOD = 1 * MiB + 1536 * 1024 + 0;
constexpr size_t WS_CS = 3 * MiB;
constexpr size_t WS_LRUW = 7 * MiB;
constexpr size_t WS_WIN = 8 * MiB, WIN_STRIDE = 4 * MiB;
constexpr size_t WS_WUP = 24 * MiB, WUP_STRIDE = 2 * MiB;
constexpr size_t WS_WOUT = 32 * MiB, WOUT_STRIDE = 2 * MiB;
constexpr size_t WS_WGU = 40 * MiB, WGU_STRIDE = 11 * MiB;
constexpr size_t WS_WDN = 84 * MiB, WDN_STRIDE = 5632 * 1024;
constexpr size_t WS_H = 106 * MiB;
constexpr size_t WS_Z = 170 * MiB;
constexpr size_t WS_CQKV = 298 * MiB;
constexpr size_t WS_UP = 322 * MiB;
constexpr size_t WS_KR = 434 * MiB;
constexpr size_t WS_RQ = 418 * MiB;
constexpr size_t WS_RK = 426 * MiB;
constexpr size_t WS_HID = 170 * MiB;
constexpr size_t WS_XH = 436 * MiB;
constexpr size_t WS_XG2 = 346 * MiB;
constexpr size_t WS_RSS = 500 * MiB;
constexpr size_t WS_B1 = 502 * MiB;
constexpr size_t WS_B2 = 502 * MiB + 512 * 1024;
constexpr size_t WS_END = 504 * MiB;
static_assert(WS_HID + (size_t)T * FFN * 2 <= WS_XG2 && WS_XG2 + (size_t)T * D * 2 <= WS_RQ, "xg2 placement");
static_assert(WS_HID + (size_t)T * FFN * 2 <= WS_RQ, "hid overlay");

#ifndef PROBE_MODE
#define PROBE_MODE 0
#endif
#ifndef GEMM_SP2
#define GEMM_SP2 true
#endif
#ifndef GEMM_ALIGN
#define GEMM_ALIGN true
#endif
constexpr int LDS_BYTES = 147456;
constexpr int NTHREADS = 512;

struct Args { const float* in[26]; float* out; unsigned char* ws; int ph_lo, ph_hi; };

typedef const __attribute__((address_space(4))) Args* ArgsP;
DI ArgsP args_opaque() { ArgsP p = (ArgsP)__builtin_amdgcn_kernarg_segment_ptr(); asm volatile("" : "+s"(p)); return p; }
DI Args load_args(ArgsP p) { Args a;
#pragma unroll
    for (int i = 0; i < 26; ++i) a.in[i] = p->in[i];
    a.out = p->out; a.ws = p->ws; a.ph_lo = 0; a.ph_hi = 0; return a; }
DI int bid_opaque() { int b = blockIdx.x; asm volatile("" : "+s"(b)); return b; }
DI int gdim_opaque() { int b = gridDim.x; asm volatile("" : "+s"(b)); return b; }
DI int tid_opaque(int wid) { int t = wid * 64 + (int)__builtin_amdgcn_mbcnt_hi(~0u, __builtin_amdgcn_mbcnt_lo(~0u, 0u)); asm volatile("" : "+v"(t)); return t; }

namespace pg8 {
constexpr int BM = 256, BK = 64, HALF = 128, HTB = HALF * BK * 2, STAGE_BYTES = 8 * HTB, NXCD = 8, WGM = 8;
__host__ __device__ __forceinline__ int lds_byte(int r, int c) { const int st = (r >> 4) * 2 + (c >> 5), rr = r & 15, cc = c & 31, ob = rr * 64 + cc * 2; return st * 1024 + (ob ^ (((ob >> 9) & 1) << 5)); }
__host__ __device__ __forceinline__ void stage_rc(int b, int& R, int& C) { const int st = b / 1024, sb = b % 1024, swz = sb ^ (((sb >> 9) & 1) << 5); R = (st >> 1) * 16 + swz / 64; C = (st & 1) * 32 + (swz % 64) / 2; }
__host__ __device__ __forceinline__ int perm32(int rho) { const int n = rho >> 4, i = rho & 15; return 8 * (i >> 2) + 4 * n + (i & 3); }
struct Unit { int pm, pn, kb, nk; };
struct Gemm { const h16* A; const h16* Bt; int M, N, K; };
struct StaticOrder {
    int nM, nN, nwg, G, c, ntk, kmode;
    __device__ void init(int M, int N, int G_, int c_, int K = 0, int kmode_ = 0) { nM = M / BM; nN = N / BM; nwg = nM * nN; G = G_; c = c_; ntk = K / BK; kmode = kmode_; }
    __device__ bool next(int i, Unit& u) const {
        const long L = (long)i * G + c; if (L >= nwg) return false;
        int wgid = (int)L; { const int q = nwg / NXCD, r = nwg % NXCD, xcd = wgid % NXCD, off = wgid / NXCD; wgid = (xcd < r ? xcd * (q + 1) : r * (q + 1) + (xcd - r) * q) + off; }
        const int nig = WGM * nN, gid = wgid / nig, fm = gid * WGM, gsz = (nM - fm) < WGM ? (nM - fm) : WGM;
        u.pm = fm + ((wgid % nig) % gsz); u.pn = (wgid % nig) / gsz;
        if (kmode == 1) { if (u.pn <= 1) { u.kb = 0; u.nk = 4; } else if (u.pn == 2) { u.kb = 0; u.nk = 6; } else { u.kb = 4; u.nk = 2; } }
        else { u.kb = 0; u.nk = ntk; }
        return true;
    }
};
template <class Epi, bool ALIGN_EPI = false, bool SP2 = false>
__device__ __forceinline__ void gemm_phase(LAS unsigned char* lds, const Gemm g, const StaticOrder& S, const Epi& E, const int WID_) {
    const int tid = tid_opaque(WID_), wid = __builtin_amdgcn_readfirstlane(tid >> 6), lane = tid & 63, wr = wid >> 2, wc = wid & 3, fr = lane & 15, fq = lane >> 4;
    int K_ = g.K; asm volatile("" : "+s"(K_));
    const int K = K_, nt = K / BK;
    unsigned voffA[2], voffB[2];
#pragma unroll
    for (int i = 0; i < 2; ++i) { int R, C; stage_rc(tid * 16 + i * 8192, R, C); const int Rb = Epi::PERM ? ((R & ~31) + perm32(R & 31)) : R;
        voffA[i] = (unsigned)(R * K + C) * 2u; voffB[i] = (unsigned)(Rb * K + C) * 2u; }
    const size_t kstep = (size_t)(BK * 2);
    const size_t hstep = (size_t)HALF * K * 2;
    const size_t tstep = 2 * hstep;
    const unsigned ldsw = (unsigned)wid * 1024u;
    const int aoff = lds_byte(wr * 64 + fr, fq * 8), boff = lds_byte(wc * 32 + fr, fq * 8);
#define PG8_SA(b, h) (((b) * 2 + (h)) * HTB)
#define PG8_SB(b, h) ((4 + (b) * 2 + (h)) * HTB)
#define PG8_STAGE(bufoff, gbase, voff) do { _Pragma("unroll") for (int _i = 0; _i < 2; ++_i) \
        __builtin_amdgcn_global_load_lds((const unsigned*)((const char*)(gbase) + (voff)[_i]), (LAS unsigned*)(lds + (bufoff) + ldsw + _i * 8192), 16, 0, 0); } while (0)
#define PG8_LDA(dst, b, h) do { _Pragma("unroll") for (int m = 0; m < 4; ++m) _Pragma("unroll") for (int k = 0; k < 2; ++k) dst[m][k] = *(const LAS half8*)(lds + PG8_SA(b, h) + aoff + m * 2048 + k * 1024); } while (0)
#define PG8_LDB(dst, b, h) do { _Pragma("unroll") for (int n = 0; n < 2; ++n) _Pragma("unroll") for (int k = 0; k < 2; ++k) dst[n][k] = *(const LAS half8*)(lds + PG8_SB(b, h) + boff + n * 2048 + k * 1024); } while (0)
#define PG8_MMA(ai, bj, At, Bt) do { __builtin_amdgcn_s_setprio(1); _Pragma("unroll") for (int m = 0; m < 4; ++m) _Pragma("unroll") for (int n = 0; n < 2; ++n) _Pragma("unroll") for (int k = 0; k < 2; ++k) \
        acc[ai][bj][m][n] = __builtin_amdgcn_mfma_f32_16x16x32_f16(Bt[n][k], At[m][k], acc[ai][bj][m][n], 0, 0, 0); __builtin_amdgcn_s_setprio(0); } while (0)
#define PG8_WAIT_V(n) asm volatile("s_waitcnt vmcnt(" #n ")" ::: "memory")
#define PG8_WAIT_L(n) asm volatile("s_waitcnt lgkmcnt(" #n ")" ::: "memory")
#define PG8_BAR __builtin_amdgcn_s_barrier()
#define PG8_SCHED __builtin_amdgcn_sched_barrier(0)
    Unit cur, nxt; int ui = 0;
    if (!S.next(0, cur)) return;
    f32x4 acc[2][2][4][2];
#pragma unroll
    for (int a = 0; a < 2; ++a)
#pragma unroll
        for (int b = 0; b < 2; ++b)
#pragma unroll
            for (int m = 0; m < 4; ++m)
#pragma unroll
                for (int n = 0; n < 2; ++n) acc[a][b][m][n] = (f32x4){0.f, 0.f, 0.f, 0.f};
    half8 At[4][2], B0[2][2], B1[2][2];
    const char* cA = (const char*)g.A + (size_t)cur.pm * tstep + (size_t)cur.kb * kstep; const char* cB = (const char*)g.Bt + (size_t)cur.pn * tstep + (size_t)cur.kb * kstep;
    if constexpr (SP2) {
        PG8_STAGE(PG8_SB(0, 0), cB, voffB); PG8_STAGE(PG8_SB(0, 1), cB + hstep, voffB); PG8_STAGE(PG8_SA(0, 0), cA, voffA); PG8_STAGE(PG8_SA(0, 1), cA + hstep, voffA);
        if (wr == 1) PG8_BAR;
        PG8_WAIT_V(2); PG8_BAR;
        PG8_STAGE(PG8_SB(1, 0), cB + kstep, voffB); PG8_STAGE(PG8_SA(1, 0), cA + kstep, voffA); PG8_STAGE(PG8_SB(1, 1), cB + hstep + kstep, voffB);
        PG8_WAIT_V(6); PG8_BAR;
    } else {
    PG8_STAGE(PG8_SB(0, 0), cB, voffB); PG8_STAGE(PG8_SA(0, 0), cA, voffA); PG8_STAGE(PG8_SB(0, 1), cB + hstep, voffB); PG8_STAGE(PG8_SA(0, 1), cA + hstep, voffA);
    if (wr == 1) PG8_BAR;
    PG8_WAIT_V(4); PG8_BAR;
    PG8_STAGE(PG8_SB(1, 0), cB + kstep, voffB); PG8_STAGE(PG8_SA(1, 0), cA + kstep, voffA); PG8_STAGE(PG8_SB(1, 1), cB + hstep + kstep, voffB);
    PG8_WAIT_V(6); PG8_BAR;
    }
    for (;;) {
        const bool has_next = S.next(ui + 1, nxt);
        const char* nA = has_next ? (const char*)g.A + (size_t)nxt.pm * tstep + (size_t)nxt.kb * kstep : cA; const char* nB = has_next ? (const char*)g.Bt + (size_t)nxt.pn * tstep + (size_t)nxt.kb * kstep : cB;
        const int ntu = cur.nk;
        for (int t = 0; t < ntu; t += 2) {
            const bool last = (t == ntu - 2);
            const char* a1 = cA + (size_t)(t + 1) * kstep;
            const char* a2 = last ? nA : cA + (size_t)(t + 2) * kstep; const char* b2 = last ? nB : cB + (size_t)(t + 2) * kstep;
            const char* a3 = a2 + kstep; const char* b3 = b2 + kstep;
            if constexpr (SP2) {
            PG8_LDB(B0, 0, 0); PG8_LDB(B1, 0, 1); PG8_SCHED; PG8_LDA(At, 0, 0); PG8_STAGE(PG8_SA(1, 1), a1 + hstep, voffA);
            PG8_WAIT_V(8); PG8_WAIT_L(0); PG8_BAR; PG8_MMA(0, 0, At, B0); PG8_MMA(0, 1, At, B1); PG8_BAR; PG8_SCHED;
            PG8_LDA(At, 0, 1); PG8_STAGE(PG8_SB(0, 0), b2, voffB); PG8_STAGE(PG8_SB(0, 1), b2 + hstep, voffB); PG8_STAGE(PG8_SA(0, 0), a2, voffA);
            PG8_WAIT_V(8); PG8_WAIT_L(0); PG8_BAR; PG8_MMA(1, 0, At, B0); PG8_MMA(1, 1, At, B1); PG8_BAR; PG8_SCHED;
            PG8_LDB(B0, 1, 0); PG8_LDB(B1, 1, 1); PG8_SCHED; PG8_LDA(At, 1, 0); PG8_STAGE(PG8_SA(0, 1), a2 + hstep, voffA);
            PG8_WAIT_V(8); PG8_WAIT_L(0); PG8_BAR; PG8_MMA(0, 0, At, B0); PG8_MMA(0, 1, At, B1); PG8_BAR; PG8_SCHED;
            PG8_LDA(At, 1, 1); PG8_STAGE(PG8_SB(1, 0), b3, voffB); PG8_STAGE(PG8_SB(1, 1), b3 + hstep, voffB); PG8_STAGE(PG8_SA(1, 0), a3, voffA);
            PG8_WAIT_V(8); PG8_WAIT_L(0); PG8_BAR; PG8_MMA(1, 0, At, B0); PG8_MMA(1, 1, At, B1); PG8_BAR; PG8_SCHED;
            } else {
            PG8_LDB(B0, 0, 0); PG8_SCHED; PG8_LDA(At, 0, 0); PG8_STAGE(PG8_SA(1, 1), a1 + hstep, voffA);
            PG8_WAIT_L(8); PG8_BAR; PG8_WAIT_L(0); PG8_MMA(0, 0, At, B0); PG8_BAR; PG8_SCHED;
            PG8_LDB(B1, 0, 1); PG8_STAGE(PG8_SB(0, 0), b2, voffB);
            PG8_BAR; PG8_WAIT_L(0); PG8_MMA(0, 1, At, B1); PG8_BAR;
            PG8_LDA(At, 0, 1); PG8_STAGE(PG8_SA(0, 0), a2, voffA);
            PG8_BAR; PG8_WAIT_L(0); PG8_MMA(1, 0, At, B0); PG8_BAR; PG8_SCHED;
            PG8_STAGE(PG8_SB(0, 1), b2 + hstep, voffB);
            PG8_WAIT_V(6); PG8_BAR; PG8_MMA(1, 1, At, B1); PG8_BAR;
            PG8_LDB(B0, 1, 0); PG8_SCHED; PG8_LDA(At, 1, 0); PG8_STAGE(PG8_SA(0, 1), a2 + hstep, voffA);
            PG8_WAIT_L(8); PG8_BAR; PG8_WAIT_L(0); PG8_MMA(0, 0, At, B0); PG8_BAR; PG8_SCHED;
            PG8_LDB(B1, 1, 1); PG8_STAGE(PG8_SB(1, 0), b3, voffB);
            PG8_BAR; PG8_WAIT_L(0); PG8_MMA(0, 1, At, B1); PG8_BAR;
            PG8_LDA(At, 1, 1); PG8_STAGE(PG8_SA(1, 0), a3, voffA);
            PG8_BAR; PG8_WAIT_L(0); PG8_MMA(1, 0, At, B0); PG8_BAR; PG8_SCHED;
            PG8_STAGE(PG8_SB(1, 1), b3 + hstep, voffB);
            PG8_WAIT_V(6); PG8_BAR; PG8_MMA(1, 1, At, B1); PG8_BAR;
                    }
        }
        if constexpr (ALIGN_EPI) { if (wr == 0) PG8_BAR; }
        E(acc, cur, wr, wc, fr, fq);
        if (!has_next) break;
#pragma unroll
        for (int a = 0; a < 2; ++a)
#pragma unroll
            for (int b = 0; b < 2; ++b)
#pragma unroll
                for (int m = 0; m < 4; ++m)
#pragma unroll
                    for (int n = 0; n < 2; ++n) acc[a][b][m][n] = (f32x4){0.f, 0.f, 0.f, 0.f};
        cur = nxt; cA = nA; cB = nB; ++ui;
        if constexpr (ALIGN_EPI) { if (wr == 1) PG8_BAR; }
    }
    PG8_WAIT_V(0);
    if constexpr (!ALIGN_EPI) { if (wr == 0) PG8_BAR; }
    PG8_BAR;
#undef PG8_SA
#undef PG8_SB
#undef PG8_STAGE
#undef PG8_LDA
#undef PG8_LDB
#undef PG8_MMA
#undef PG8_WAIT_V
#undef PG8_WAIT_L
#undef PG8_BAR
#undef PG8_SCHED
}
}

DI half4 cvt4(f32x4 v) { half4 r; r[0] = (h16)v[0]; r[1] = (h16)v[1]; r[2] = (h16)v[2]; r[3] = (h16)v[3]; return r; }
DI float siluf(float v) { return v * __builtin_amdgcn_rcpf(1.0f + __expf(-v)); }

struct EpiF16 {
    static constexpr bool PERM = true;
    h16* O; int ldc;
    DI void operator()(const f32x4 (&acc)[2][2][4][2], const pg8::Unit& u, int wr, int wc, int fr, int fq) const {
        const int row0 = u.pm * 256 + wr * 64 + fr, col0 = u.pn * 256 + wc * 32 + 8 * fq;
#pragma unroll
        for (int ai = 0; ai < 2; ++ai)
#pragma unroll
            for (int m = 0; m < 4; ++m) { h16* rowp = O + (size_t)(row0 + ai * 128 + m * 16) * ldc + col0;
#pragma unroll
                for (int bj = 0; bj < 2; ++bj) { half8 w; const f32x4 v0 = acc[ai][bj][m][0], v1 = acc[ai][bj][m][1];
                    w[0] = (h16)v0[0]; w[1] = (h16)v0[1]; w[2] = (h16)v0[2]; w[3] = (h16)v0[3]; w[4] = (h16)v1[0]; w[5] = (h16)v1[1]; w[6] = (h16)v1[2]; w[7] = (h16)v1[3];
                    *(half8*)(rowp + bj * 128) = w; } }
    }
};
DI float shfl_xor_f(float v, int o, int lane) { return __builtin_bit_cast(float, __builtin_amdgcn_ds_bpermute((lane ^ o) << 2, __builtin_bit_cast(int, v))); }
struct EpiZ {
    static constexpr bool PERM = true;
    h16* O; int ldc; const float* rss; const float* bias; int ldb;
    DI void operator()(const f32x4 (&acc)[2][2][4][2], const pg8::Unit& u, int wr, int wc, int fr, int fq) const {
        const int row0 = u.pm * 256 + wr * 64 + fr, col0 = u.pn * 256 + wc * 32 + 8 * fq;
        const int b = (u.pm * 256) >> 11;
        f32x4 bv[2][2];
#pragma unroll
        for (int bj = 0; bj < 2; ++bj)
#pragma unroll
            for (int n = 0; n < 2; ++n) bv[bj][n] = *(const f32x4*)(bias + (size_t)b * ldb + col0 + bj * 128 + 4 * n);
#pragma unroll
        for (int ai = 0; ai < 2; ++ai)
#pragma unroll
            for (int m = 0; m < 4; ++m) { const int row = row0 + ai * 128 + m * 16; const float rstd = rsqrtf(rss[row] * (1.0f / D) + EPS);
                h16* rowp = O + (size_t)row * ldc + col0;
#pragma unroll
                for (int bj = 0; bj < 2; ++bj) { half8 w;
#pragma unroll
                    for (int n = 0; n < 2; ++n)
#pragma unroll
                        for (int j = 0; j < 4; ++j) w[4 * n + j] = (h16)(acc[ai][bj][m][n][j] * rstd + bv[bj][n][j]);
                    *(half8*)(rowp + bj * 128) = w; } }
    }
};
struct EpiSwiGLU {
    static constexpr bool PERM = true;
    h16* O; int ldc; const float* rss; const float* bias;
    DI void operator()(const f32x4 (&acc)[2][2][4][2], const pg8::Unit& u, int wr, int wc, int fr, int fq) const {
        const int row0 = u.pm * 256 + wr * 64 + fr, col0 = u.pn * 128 + wc * 32 + 8 * fq;
        const int b = (u.pm * 256) >> 11;
        f32x4 bg[2], bu[2];
#pragma unroll
        for (int n = 0; n < 2; ++n) { bg[n] = *(const f32x4*)(bias + (size_t)b * (2 * FFN) + col0 + 4 * n); bu[n] = *(const f32x4*)(bias + (size_t)b * (2 * FFN) + FFN + col0 + 4 * n); }
#pragma unroll
        for (int ai = 0; ai < 2; ++ai)
#pragma unroll
            for (int m = 0; m < 4; ++m) { const int row = row0 + ai * 128 + m * 16; const float rstd = rsqrtf(rss[row] * (1.0f / D) + EPS); half8 w;
#pragma unroll
                for (int n = 0; n < 2; ++n)
#pragma unroll
                    for (int j = 0; j < 4; ++j) { const float gt = acc[ai][0][m][n][j] * rstd + bg[n][j], up = acc[ai][1][m][n][j] * rstd + bu[n][j]; w[4 * n + j] = (h16)(siluf(gt) * up); }
                *(half8*)(O + (size_t)row * ldc + col0) = w; }
    }
};
struct EpiRes {
    static constexpr bool PERM = true;
    h16* x; const float* gate; int ldg; h16* xg; const float* gain; const float* sc; float* rss;
    DI void operator()(const f32x4 (&acc)[2][2][4][2], const pg8::Unit& u, int wr, int wc, int fr, int fq) const {
        const int row0 = u.pm * 256 + wr * 64 + fr, col0 = u.pn * 256 + wc * 32 + 8 * fq;
        const int b = (u.pm * 256) >> 11, lane = fr + 16 * fq;
        float ss[2][4];
#pragma unroll
        for (int ai = 0; ai < 2; ++ai)
#pragma unroll
            for (int m = 0; m < 4; ++m) ss[ai][m] = 0.f;
#pragma unroll
        for (int bj = 0; bj < 2; ++bj) {
            f32x4 gv[2], gm[2];
#pragma unroll
            for (int n = 0; n < 2; ++n) { gv[n] = *(const f32x4*)(gate + (size_t)b * ldg + col0 + bj * 128 + 4 * n);
                const f32x4 g4 = *(const f32x4*)(gain + col0 + bj * 128 + 4 * n), s4 = *(const f32x4*)(sc + (size_t)b * ldg + col0 + bj * 128 + 4 * n); gm[n] = g4 * (s4 + 1.0f); }
#pragma unroll
            for (int ai = 0; ai < 2; ++ai) {
                half8 xv[4];
#pragma unroll
                for (int m = 0; m < 4; ++m) xv[m] = *(const half8*)(x + (size_t)(row0 + ai * 128 + m * 16) * D + col0 + bj * 128);
                __builtin_amdgcn_sched_barrier(0);
#pragma unroll
                for (int m = 0; m < 4; ++m) { const int row = row0 + ai * 128 + m * 16; half8 w, wg; float s_ = 0.f;
#pragma unroll
                    for (int n = 0; n < 2; ++n)
#pragma unroll
                        for (int j = 0; j < 4; ++j) { const h16 hn = (h16)((float)xv[m][4 * n + j] + gv[n][j] * acc[ai][bj][m][n][j]); const float xr = (float)hn;
                            w[4 * n + j] = hn; s_ += xr * xr; wg[4 * n + j] = (h16)(xr * gm[n][j]); }
                    *(half8*)(x + (size_t)row * D + col0 + bj * 128) = w; ss[ai][m] += s_;
                    if (xg) *(half8*)(xg + (size_t)row * D + col0 + bj * 128) = wg; }
            }
        }
#pragma unroll
        for (int ai = 0; ai < 2; ++ai)
#pragma unroll
            for (int m = 0; m < 4; ++m) { float t = ss[ai][m]; t += shfl_xor_f(t, 16, lane); t += shfl_xor_f(t, 32, lane);
                if (fq == 0) unsafeAtomicAdd(rss + row0 + ai * 128 + m * 16, t); }
    }
};

struct EpiNull {
    static constexpr bool PERM = true;
    float* dummy;
    DI void operator()(const f32x4 (&acc)[2][2][4][2], const pg8::Unit& u, int wr, int wc, int fr, int fq) const {
        float t = 0.f;
#pragma unroll
        for (int ai = 0; ai < 2; ++ai)
#pragma unroll
            for (int bj = 0; bj < 2; ++bj)
#pragma unroll
                for (int m = 0; m < 4; ++m)
#pragma unroll
                    for (int n = 0; n < 2; ++n) t += acc[ai][bj][m][n][0] + acc[ai][bj][m][n][1] + acc[ai][bj][m][n][2] + acc[ai][bj][m][n][3];
        if (t == 1.2345678e33f) dummy[u.pm + wr + wc + fr + fq] = t;
    }
};
DI float wave_sum(float v, int lane) {
#pragma unroll
    for (int o = 32; o >= 1; o >>= 1) v += shfl_xor_f(v, o, lane);
    return v;
}
DI int crow(int reg, int hi) { return (reg & 3) + 8 * (reg >> 2) + 4 * hi; }

DI void xpose_tile(const float* __restrict__ src, int ld_src, int k0, int n0, int nvalid, h16* dst, int ldd, int dr0, int dk0, LAS float* scr, int lane, bool active) {
    if (active) {
#pragma unroll
        for (int hb = 0; hb < 2; ++hb) { float v[32];
#pragma unroll
            for (int i = 0; i < 32; ++i) { v[i] = 0.f; if (lane < nvalid) v[i] = src[(size_t)(k0 + 32 * hb + i) * ld_src + n0 + lane]; }
#pragma unroll
            for (int i = 0; i < 32; ++i) scr[(32 * hb + i) * 65 + lane] = v[i]; }
    }
    __syncthreads();
    if (active) {
        const int ic = lane & 7;
#pragma unroll
        for (int jj = 0; jj < 8; ++jj) { const int j = jj * 8 + (lane >> 3); half8 w;
#pragma unroll
            for (int e = 0; e < 8; ++e) w[e] = (h16)scr[(8 * ic + e) * 65 + j];
            *(half8*)(dst + (size_t)(dr0 + j) * ldd + dk0 + 8 * ic) = w; }
    }
    __syncthreads();
}

DI void p0_prologue(const Args& a, LAS unsigned char* lds, const int WID_) {
    const int tid = tid_opaque(WID_), lane = tid & 63, wave = tid >> 6;
    unsigned char* ws = a.ws;
    {
        LAS float* scr = (LAS float*)lds + wave * (64 * 65);
        constexpr int PER_LAYER = 512 + 144 + 256 + 1408 + 704 + 12;
        const int total = DEPTH * PER_LAYER, stride = gdim_opaque() * 8;
        for (int base = bid_opaque() * 8; base < total; base += stride) {
            const int id = base + wave; const bool active = id < total;
            const float* src = nullptr; int ld = 0, k0 = 0, n0 = 0, nvalid = 0, ldd = 0, dr0 = 0, dk0 = 0; h16* dst = nullptr;
            if (active) {
                const int l = id / PER_LAYER; int t = id - l * PER_LAYER;
                if (t < 512) { const int kt = t >> 5, nt = t & 31; src = a.in[6] + (size_t)l * D * DIN; ld = DIN; k0 = 64 * kt; n0 = 64 * nt; nvalid = DIN - n0; nvalid = nvalid < 0 ? 0 : (nvalid > 64 ? 64 : nvalid);
                    dst = (h16*)(ws + WS_WIN + l * WIN_STRIDE); ldd = D; dr0 = n0; dk0 = k0; }
                else if ((t -= 512) < 144) { const int kt = t / 24, nt = t - kt * 24; dst = (h16*)(ws + WS_WUP + l * WUP_STRIDE); ldd = KUP; dr0 = 64 * nt; dk0 = 64 * kt; nvalid = 0; src = a.in[8];
                    if (nt < 9) { if (kt < 4) { src = a.in[8] + (size_t)l * 256 * 576; ld = 576; k0 = 64 * kt; n0 = 64 * nt; nvalid = 64; } }
                    else if (nt < 21) { if (kt >= 4) { src = a.in[10] + (size_t)l * 128 * 768; ld = 768; k0 = 64 * (kt - 4); n0 = 64 * (nt - 9); nvalid = 64; } } }
                else if ((t -= 144) < 256) { const int kt = t >> 4, nt = t & 15; src = a.in[19] + (size_t)l * D * D; ld = D; k0 = 64 * kt; n0 = 64 * nt; nvalid = 64; dst = (h16*)(ws + WS_WOUT + l * WOUT_STRIDE); ldd = D; dr0 = n0; dk0 = k0; }
                else if ((t -= 256) < 1408) { const int kt = t / 88, nt = t - kt * 88; src = a.in[21] + (size_t)l * D * 2 * FFN; ld = 2 * FFN; k0 = 64 * kt; n0 = 64 * nt; nvalid = 64;
                    const int isup = n0 >= FFN, u0 = n0 - isup * FFN; dst = (h16*)(ws + WS_WGU + l * WGU_STRIDE); ldd = D; dr0 = 256 * (u0 >> 7) + 128 * isup + (u0 & 127); dk0 = k0; }
                else if ((t -= 1408) < 704) { const int kt = t >> 4, nt = t & 15; src = a.in[22] + (size_t)l * FFN * D; ld = D; k0 = 64 * kt; n0 = 64 * nt; nvalid = 64; dst = (h16*)(ws + WS_WDN + l * WDN_STRIDE); ldd = FFN; dr0 = n0; dk0 = k0; }
                else { t -= 704; const int gate = t / 6, g = t - gate * 6; src = a.in[gate ? 16 : 14] + (size_t)l * 6 * 4096 + g * 4096; ld = 64; k0 = 0; n0 = 0; nvalid = 64;
                    dst = (h16*)(ws + WS_LRUW) + (size_t)((l * 2 + gate) * 6 + g) * 4096; ldd = 64; dr0 = 0; dk0 = 0; }
            }
            xpose_tile(src, ld, k0, n0, nvalid, dst, ldd, dr0, dk0, scr, lane, active);
        }
    }
    __syncthreads();
    {
        LAS float* cact = (LAS float*)lds;
        LAS float* red = (LAS float*)(lds + 65536);
        const float* c = a.in[1];
        for (int idx = tid; idx < NB * D; idx += NTHREADS) { const int b = idx >> 10, k = idx & 1023; cact[k * 16 + b] = siluf(c[idx]); }
        __syncthreads();
        float* modv = (float*)(ws + WS_MOD); float* fmod = (float*)(ws + WS_FMOD);
        for (int item = bid_opaque(); item < 416; item += gdim_opaque()) {
            const float* W; const float* bias; float* outp; int ldw, n0;
            if (item < 384) { const int l = item / 96; n0 = (item - l * 96) * 64; W = a.in[3] + (size_t)l * D * 6144; ldw = 6144; bias = a.in[4] + l * 6144; outp = modv + (size_t)l * 16 * 6144; }
            else { n0 = (item - 384) * 64; W = a.in[24]; ldw = 2048; bias = a.in[25]; outp = fmod; }
            float acc[16];
#pragma unroll
            for (int b = 0; b < 16; ++b) acc[b] = 0.f;
            for (int kk0 = 0; kk0 < 128; kk0 += 16) { float wv[16];
#pragma unroll
                for (int u = 0; u < 16; ++u) wv[u] = W[(size_t)(wave * 128 + kk0 + u) * ldw + n0 + lane];
#pragma unroll
                for (int u = 0; u < 16; ++u) { const int k = wave * 128 + kk0 + u; const float w = wv[u];
#pragma unroll
                    for (int q = 0; q < 4; ++q) { const f32x4 cv = *(const LAS f32x4*)(cact + k * 16 + 4 * q);
                        acc[4 * q + 0] += cv[0] * w; acc[4 * q + 1] += cv[1] * w; acc[4 * q + 2] += cv[2] * w; acc[4 * q + 3] += cv[3] * w; } } }
#pragma unroll
            for (int b = 0; b < 16; ++b) red[(wave * 16 + b) * 64 + lane] = acc[b];
            __syncthreads();
            for (int o = tid; o < 1024; o += NTHREADS) { const int b = o >> 6, j = o & 63; float s = 0.f;
#pragma unroll
                for (int w = 0; w < 8; ++w) s += red[(w * 16 + b) * 64 + j];
                outp[(size_t)b * ldw + n0 + j] = s + bias[n0 + j]; }
            __syncthreads();
        }
    }
    {
        f32x4* r = (f32x4*)(ws + WS_RSS);
        for (int idx = bid_opaque() * NTHREADS + tid; idx < 9 * T / 4; idx += gdim_opaque() * NTHREADS) r[idx] = (f32x4){0.f, 0.f, 0.f, 0.f};
    }
    {
        f32x2* cs = (f32x2*)(ws + WS_CS); const int* pos = (const int*)a.in[2];
        for (int idx = bid_opaque() * NTHREADS + tid; idx < T * 16; idx += gdim_opaque() * NTHREADS) {
            const int tok = idx >> 4, j = idx & 15;
            const float inv = powf(10000.0f, -(float)j * 0.0625f);
            const float ang = (float)pos[tok] * inv;
            f32x2 r; r[0] = cosf(ang); r[1] = sinf(ang); cs[idx] = r;
        }
    }
}

DI void p0b_phase(const Args& a, LAS unsigned char* lds, const int WID_) {
    const int tid = tid_opaque(WID_), lane = tid & 63, wave = tid >> 6;
    unsigned char* ws = a.ws;
    const float* modv = (const float*)(ws + WS_MOD);
    {
        const float* x = a.in[0]; h16* XH = (h16*)(ws + WS_XH); h16* XG = (h16*)(ws + WS_H); float* rss = (float*)(ws + WS_RSS);
        const float* gain = a.in[5];
        for (int row = bid_opaque() * 8 + wave; row < T; row += gdim_opaque() * 8) {
            const int b = row >> 11; float ss = 0.f;
#pragma unroll
            for (int i = 0; i < 2; ++i) { const int col = i * 512 + lane * 8; half8 w, wg;
#pragma unroll
                for (int q = 0; q < 2; ++q) { const f32x4 v = *(const f32x4*)(x + (size_t)row * D + col + 4 * q), g = *(const f32x4*)(gain + col + 4 * q), sc = *(const f32x4*)(modv + (size_t)b * 6144 + 1 * D + col + 4 * q);
#pragma unroll
                    for (int j = 0; j < 4; ++j) { const h16 hn = (h16)v[j]; const float xr = (float)hn; w[4 * q + j] = hn; ss += xr * xr; wg[4 * q + j] = (h16)(xr * g[j] * (1.0f + sc[j])); } }
                *(half8*)(XH + (size_t)row * D + col) = w; *(half8*)(XG + (size_t)row * D + col) = wg; }
            ss = wave_sum(ss, lane);
            if (lane == 0) rss[row] = ss;
        }
    }
    __syncthreads();
    {
        LAS float* shl = (LAS float*)lds;
        LAS float* red = (LAS float*)(lds + 65536);
        for (int item = bid_opaque(); item < 4 * 119; item += gdim_opaque()) {
            const int l = item / 119, it = item - l * 119;
            const float* W; float* outp; int ldw, n0, nmax, ldo, shoff;
            if (it < 31) { n0 = it * 64; W = a.in[6] + (size_t)l * D * DIN; ldw = DIN; nmax = DIN; outp = (float*)(ws + WS_B1) + (size_t)l * 16 * DINP; ldo = DINP; shoff = 0; }
            else { n0 = (it - 31) * 64; W = a.in[21] + (size_t)l * D * 2 * FFN; ldw = 2 * FFN; nmax = 2 * FFN; outp = (float*)(ws + WS_B2) + (size_t)l * 16 * 2 * FFN; ldo = 2 * FFN; shoff = 3 * D; }
            const float* modl = modv + (size_t)l * 16 * 6144;
            for (int idx = tid; idx < NB * D; idx += NTHREADS) { const int b = idx >> 10, k = idx & 1023; shl[k * 16 + b] = modl[(size_t)b * 6144 + shoff + k]; }
            __syncthreads();
            const bool colok = (n0 + lane) < nmax;
            float acc[16];
#pragma unroll
            for (int b = 0; b < 16; ++b) acc[b] = 0.f;
            for (int kk0 = 0; kk0 < 128; kk0 += 16) { float wv[16];
#pragma unroll
                for (int u = 0; u < 16; ++u) wv[u] = colok ? W[(size_t)(wave * 128 + kk0 + u) * ldw + n0 + lane] : 0.f;
#pragma unroll
                for (int u = 0; u < 16; ++u) { const int k = wave * 128 + kk0 + u; const float w = wv[u];
#pragma unroll
                    for (int q = 0; q < 4; ++q) { const f32x4 cv = *(const LAS f32x4*)(shl + k * 16 + 4 * q);
                        acc[4 * q + 0] += cv[0] * w; acc[4 * q + 1] += cv[1] * w; acc[4 * q + 2] += cv[2] * w; acc[4 * q + 3] += cv[3] * w; } } }
#pragma unroll
            for (int b = 0; b < 16; ++b) red[(wave * 16 + b) * 64 + lane] = acc[b];
            __syncthreads();
            for (int o = tid; o < 1024; o += NTHREADS) { const int b = o >> 6, j = o & 63; float sm = 0.f;
#pragma unroll
                for (int w = 0; w < 8; ++w) sm += red[(w * 16 + b) * 64 + j];
                outp[(size_t)b * ldo + n0 + j] = sm; }
            __syncthreads();
        }
    }
}

DI void final_phase(const Args& a, const int WID_) {
    const int tid = tid_opaque(WID_), lane = tid & 63, wave = tid >> 6;
    unsigned char* ws = a.ws;
    const h16* XH = (const h16*)(ws + WS_XH); const float* rss = (const float*)(ws + WS_RSS) + (size_t)8 * T; const float* fmod = (const float*)(ws + WS_FMOD);
    const float* gain = a.in[23]; float* out = a.out;
    for (int row = bid_opaque() * 8 + wave; row < T; row += gdim_opaque() * 8) {
        const int b = row >> 11; const float rstd = rsqrtf(rss[row] * (1.0f / D) + EPS);
#pragma unroll
        for (int i = 0; i < 2; ++i) { const int col = i * 512 + lane * 8; const half8 v = *(const half8*)(XH + (size_t)row * D + col);
#pragma unroll
            for (int q = 0; q < 2; ++q) { const f32x4 g = *(const f32x4*)(gain + col + 4 * q), sc = *(const f32x4*)(fmod + (size_t)b * 2048 + D + col + 4 * q), sh = *(const f32x4*)(fmod + (size_t)b * 2048 + col + 4 * q); f32x4 y;
#pragma unroll
                for (int j = 0; j < 4; ++j) y[j] = (float)v[4 * q + j] * rstd * g[j] * (1.0f + sc[j]) + sh[j];
                *(f32x4*)(out + (size_t)row * D + col + 4 * q) = y; } }
    }
}

DI void prep_phase(const Args& a, int l, const int WID_) {
    const int tid = tid_opaque(WID_), lane = tid & 63, wave = tid >> 6;
    unsigned char* ws = a.ws;
    const h16* Z = (const h16*)(ws + WS_Z); h16* CQKV = (h16*)(ws + WS_CQKV); h16* KR = (h16*)(ws + WS_KR); h16* RQ = (h16*)(ws + WS_RQ); h16* RK = (h16*)(ws + WS_RK);
    const f32x2* cs = (const f32x2*)(ws + WS_CS);
    const float* qn = a.in[7] + l * 256; const float* kvn = a.in[9] + l * 128;
    const f32x4 qg = *(const f32x4*)(qn + 4 * lane); const f32x2 kg = *(const f32x2*)(kvn + 2 * lane);
    const int hh = lane >> 4, j = lane & 15;
    for (int tok = bid_opaque() * 8 + wave; tok < T; tok += gdim_opaque() * 8) {
        const h16* zr = Z + (size_t)tok * DINP; const int b = tok >> 11, s = tok & 2047;
        const half4 cq = *(const half4*)(zr + C_CQ + 4 * lane); const half2v ck = *(const half2v*)(zr + C_CKV + 2 * lane);
        const float kr1 = (float)zr[C_KR + j], kr2 = (float)zr[C_KR + 16 + j];
        const float q1 = (float)zr[C_RQ + 32 * hh + j], q2 = (float)zr[C_RQ + 32 * hh + 16 + j];
        const float k1 = (float)zr[C_RK + 32 * hh + j], k2 = (float)zr[C_RK + 32 * hh + 16 + j];
        const f32x2 c = cs[(size_t)tok * 16 + j];
        float f0 = (float)cq[0], f1 = (float)cq[1], f2 = (float)cq[2], f3 = (float)cq[3];
        float ssq = wave_sum(f0 * f0 + f1 * f1 + f2 * f2 + f3 * f3, lane);
        const float rq = rsqrtf(ssq * (1.0f / 256.0f) + EPS);
        half4 oq; oq[0] = (h16)(f0 * rq * qg[0]); oq[1] = (h16)(f1 * rq * qg[1]); oq[2] = (h16)(f2 * rq * qg[2]); oq[3] = (h16)(f3 * rq * qg[3]);
        *(half4*)(CQKV + (size_t)tok * KUP + 4 * lane) = oq;
        const float g0 = (float)ck[0], g1 = (float)ck[1];
        float ssk = wave_sum(g0 * g0 + g1 * g1, lane);
        const float rk = rsqrtf(ssk * (1.0f / 128.0f) + EPS);
        half2v ok; ok[0] = (h16)(g0 * rk * kg[0]); ok[1] = (h16)(g1 * rk * kg[1]);
        *(half2v*)(CQKV + (size_t)tok * KUP + 256 + 2 * lane) = ok;
        if (hh == 0) { h16* d0 = KR + (size_t)tok * 32; d0[j] = (h16)(kr1 * c[0] - kr2 * c[1]); d0[16 + j] = (h16)(kr1 * c[1] + kr2 * c[0]); }
        { h16* dq = RQ + ((size_t)(b * 4 + hh) * SEQ + s) * 32; dq[j] = (h16)(q1 * c[0] - q2 * c[1]); dq[16 + j] = (h16)(q1 * c[1] + q2 * c[0]);
          const float ks = 0.17677669529663687f;
          h16* dk = RK + ((size_t)(b * 4 + hh) * SEQ + s) * 32; dk[j] = (h16)((k1 * c[0] - k2 * c[1]) * ks); dk[16 + j] = (h16)((k1 * c[1] + k2 * c[0]) * ks); }
    }
}

template <bool RET>
DI void attn_unit(const Args& a, int l, int b, int h, int qb, LAS unsigned char* lds, const int WID_) {
    constexpr int DK = RET ? 32 : 96, KS = DK / 16, KSTR = RET ? 80 : 208, VSTR = 192, CPR = DK / 8;
    constexpr int TK = 128;
    constexpr int KBUF = TK * 208, VOFF = 2 * KBUF, VBUF = TK * VSTR, NKC = RET ? 1 : 3;
    const int tid = tid_opaque(WID_), lane = tid & 63, wave = WID_, l32 = lane & 31, hi = lane >> 5;
    unsigned char* ws = a.ws;
    const h16* UPb = (const h16*)(ws + WS_UP) + (size_t)b * SEQ * NUP;
    const h16* Qp = RET ? (const h16*)(ws + WS_RQ) + (size_t)(b * 4 + h) * SEQ * 32 : UPb + 96 * h;
    const h16* Kp = RET ? (const h16*)(ws + WS_RK) + (size_t)(b * 4 + h) * SEQ * 32 : UPb + 576 + 128 * h;
    const h16* KRp = (const h16*)(ws + WS_KR) + (size_t)b * SEQ * 32;
    const h16* Vp = RET ? (const h16*)(ws + WS_Z) + (size_t)b * SEQ * DINP + C_RV + 64 * h : UPb + 576 + 128 * h + 64;
    constexpr int vld = RET ? DINP : NUP, qld = RET ? 32 : NUP, kld = RET ? 32 : NUP;
    constexpr float QS = 0.10206207261596577f * 1.4426950408889634f;
    const int qrow = 256 * qb + 32 * wave + l32;
    const int qmax_w = 256 * qb + 32 * wave + 31, qmin_w = 256 * qb + 32 * wave;
    half8 qf[KS];
#pragma unroll
    for (int s = 0; s < KS; ++s) qf[s] = *(const half8*)(Qp + (size_t)qrow * qld + 16 * s + 8 * hi);
    if (!RET) {
        const f32x2* csp = (const f32x2*)(ws + WS_CS) + (size_t)(b * SEQ + qrow) * 16 + 8 * hi;
#pragma unroll
        for (int e = 0; e < 8; ++e) { const f32x2 c = csp[e]; const float x1 = (float)qf[KS - 2][e], x2 = (float)qf[KS - 1][e];
            qf[KS - 2][e] = (h16)(x1 * c[0] - x2 * c[1]); qf[KS - 1][e] = (h16)(x1 * c[1] + x2 * c[0]); }
    }
    f32x16 oacc[2];
#pragma unroll
    for (int i = 0; i < 16; ++i) { oacc[0][i] = 0.f; oacc[1][i] = 0.f; }
    float m_run = -INFINITY, l_run = 0.f;
    const float lg = RET ? log2f(1.0f - exp2f(-5.0f - (float)h)) : 0.f;
    float Bc[RET ? 2 : 1][RET ? 16 : 1];
    if (RET) {
#pragma unroll
        for (int mt = 0; mt < 2; ++mt)
#pragma unroll
            for (int i = 0; i < 16; ++i) Bc[mt][i] = __builtin_amdgcn_exp2f(-lg * (float)(32 * mt + crow(i, hi)));
    }
    int krow[NKC], kcc[NKC];
#pragma unroll
    for (int i = 0; i < NKC; ++i) { const int c = tid + 512 * i; krow[i] = c / CPR; kcc[i] = c - krow[i] * CPR; }
    const int vcc = tid & 7;
    const int nkt2 = 2 * (qb + 1);
    half8 kreg[NKC], vreg[2];
    auto gload = [&](int kt2) {
#pragma unroll
        for (int i = 0; i < NKC; ++i) kreg[i] = (RET || kcc[i] < 8) ? *(const half8*)(Kp + (size_t)(TK * kt2 + krow[i]) * kld + kcc[i] * 8) : *(const half8*)(KRp + (size_t)(TK * kt2 + krow[i]) * 32 + (kcc[i] - 8) * 8);
#pragma unroll
        for (int i = 0; i < 2; ++i) vreg[i] = *(const half8*)(Vp + (size_t)(TK * kt2 + (tid >> 3) + 64 * i) * vld + vcc * 8);
    };
    gload(0);
    const int li = lane & 15, q4 = li >> 2, p4 = li & 3, g1 = (lane >> 4) & 1;
    auto compute = [&](const int kt, LAS unsigned char* Kt, LAS unsigned char* Vt) {
        if (64 * kt <= qmax_w) {
            f32x16 sv[2];
#pragma unroll
            for (int i = 0; i < 16; ++i) { sv[0][i] = 0.f; sv[1][i] = 0.f; }
#pragma unroll
            for (int s = 0; s < KS; ++s) {
                const half8 kf0 = *(const LAS half8*)(Kt + l32 * KSTR + (16 * s + 8 * hi) * 2);
                const half8 kf1 = *(const LAS half8*)(Kt + (32 + l32) * KSTR + (16 * s + 8 * hi) * 2);
                sv[0] = __builtin_amdgcn_mfma_f32_32x32x16_f16(kf0, qf[s], sv[0], 0, 0, 0);
                sv[1] = __builtin_amdgcn_mfma_f32_32x32x16_f16(kf1, qf[s], sv[1], 0, 0, 0);
            }
            half8 vfr[2][2][2];
#pragma unroll
            for (int mt = 0; mt < 2; ++mt)
#pragma unroll
                for (int sp = 0; sp < 2; ++sp) {
                    const int krw = 32 * mt + 16 * sp + 4 * hi + q4;
#pragma unroll
                    for (int mtv = 0; mtv < 2; ++mtv) {
                        LAS unsigned char* ap = Vt + krw * VSTR + (32 * mtv + 16 * g1 + 4 * p4) * 2;
                        const s16x4 t0 = __builtin_amdgcn_ds_read_tr16_b64_v4i16((LAS s16x4*)ap);
                        const s16x4 t1 = __builtin_amdgcn_ds_read_tr16_b64_v4i16((LAS s16x4*)(ap + 8 * VSTR));
                        const half4 h0 = __builtin_bit_cast(half4, t0), h1 = __builtin_bit_cast(half4, t1);
                        half8 vf; vf[0] = h0[0]; vf[1] = h0[1]; vf[2] = h0[2]; vf[3] = h0[3]; vf[4] = h1[0]; vf[5] = h1[1]; vf[6] = h1[2]; vf[7] = h1[3];
                        vfr[mt][sp][mtv] = vf;
                    }
                }
            __builtin_amdgcn_sched_barrier(0);
            const bool need_mask = (64 * kt + 63 > qmin_w);
            half8 pf[2][2];
            if (!RET) {
                if (need_mask) {
#pragma unroll
                    for (int mt = 0; mt < 2; ++mt)
#pragma unroll
                        for (int i = 0; i < 16; ++i) { const int key = 64 * kt + 32 * mt + crow(i, hi); if (key > qrow) sv[mt][i] = -INFINITY; }
                }
                float mx = sv[0][0];
#pragma unroll
                for (int i = 1; i < 16; ++i) mx = fmaxf(mx, sv[0][i]);
#pragma unroll
                for (int i = 0; i < 16; ++i) mx = fmaxf(mx, sv[1][i]);
                mx = fmaxf(mx, shfl_xor_f(mx, 32, lane));
                constexpr float THR = 6.0f;
                const float pm = mx * QS;
                if (__builtin_amdgcn_ballot_w64((pm - m_run) > THR) != 0ull) {
                    asm volatile("" ::: "memory");
                    const float m_new = fmaxf(m_run, pm);
                    const float alpha = __builtin_amdgcn_exp2f(m_run - m_new);
                    m_run = m_new; l_run *= alpha;
#pragma unroll
                    for (int i = 0; i < 16; ++i) { oacc[0][i] *= alpha; oacc[1][i] *= alpha; }
                }
                f32x2 ps2 = {0.f, 0.f};
#pragma unroll
                for (int mt = 0; mt < 2; ++mt)
#pragma unroll
                    for (int i = 0; i < 16; i += 2) { const f32x2 t = (f32x2){sv[mt][i], sv[mt][i + 1]} * QS - m_run;
                        f32x2 pp; pp[0] = __builtin_amdgcn_exp2f(t[0]); pp[1] = __builtin_amdgcn_exp2f(t[1]); ps2 += pp;
                        pf[mt][i >> 3][i & 7] = (h16)pp[0]; pf[mt][i >> 3][(i & 7) + 1] = (h16)pp[1]; }
                l_run += ps2[0] + ps2[1];
            } else {
                const float Aq = __builtin_amdgcn_exp2f(lg * (float)(qrow - 64 * kt));
                if (need_mask) {
#pragma unroll
                    for (int mt = 0; mt < 2; ++mt)
#pragma unroll
                        for (int i = 0; i < 16; ++i) { const int key = 64 * kt + 32 * mt + crow(i, hi); if (key > qrow) sv[mt][i] = 0.f; }
                }
#pragma unroll
                for (int mt = 0; mt < 2; ++mt)
#pragma unroll
                    for (int i = 0; i < 16; ++i) pf[mt][i >> 3][i & 7] = (h16)(sv[mt][i] * (Aq * Bc[RET ? mt : 0][RET ? i : 0]));
            }
#pragma unroll
            for (int mt = 0; mt < 2; ++mt)
#pragma unroll
                for (int sp = 0; sp < 2; ++sp)
#pragma unroll
                    for (int mtv = 0; mtv < 2; ++mtv) oacc[mtv] = __builtin_amdgcn_mfma_f32_32x32x16_f16(vfr[mt][sp][mtv], pf[mt][sp], oacc[mtv], 0, 0, 0);
        }
    };
    for (int kt2 = 0; kt2 < nkt2; ++kt2) {
        const int buf = kt2 & 1;
        LAS unsigned char* Kt = lds + buf * KBUF; LAS unsigned char* Vt = lds + VOFF + buf * VBUF;
#pragma unroll
        for (int i = 0; i < NKC; ++i) *(LAS half8*)(Kt + krow[i] * KSTR + kcc[i] * 16) = kreg[i];
#pragma unroll
        for (int i = 0; i < 2; ++i) *(LAS half8*)(Vt + ((tid >> 3) + 64 * i) * VSTR + vcc * 16) = vreg[i];
        __syncthreads();
        gload(kt2 + 1 < nkt2 ? kt2 + 1 : kt2);
        compute(2 * kt2, Kt, Vt);
        compute(2 * kt2 + 1, Kt + 64 * KSTR, Vt + 64 * VSTR);
    }
    h16* Y = (h16*)(ws + WS_H) + (size_t)(b * SEQ + qrow) * D;
    if (!RET) {
        const float lt = l_run + shfl_xor_f(l_run, 32, lane); const float inv = 1.0f / lt;
#pragma unroll
        for (int mtv = 0; mtv < 2; ++mtv)
#pragma unroll
            for (int i4 = 0; i4 < 4; ++i4) { half4 w;
#pragma unroll
                for (int j = 0; j < 4; ++j) w[j] = (h16)(oacc[mtv][4 * i4 + j] * inv);
                *(half4*)(Y + h * 64 + 32 * mtv + 8 * i4 + 4 * hi) = w; }
    } else {
        float s1 = 0.f;
#pragma unroll
        for (int i = 0; i < 16; ++i) s1 += oacc[0][i] + oacc[1][i];
        s1 += shfl_xor_f(s1, 32, lane);
        const float mu = s1 * (1.0f / 64.0f);
        float s2 = 0.f;
#pragma unroll
        for (int i = 0; i < 16; ++i) { const float d0 = oacc[0][i] - mu, d1 = oacc[1][i] - mu; s2 += d0 * d0 + d1 * d1; }
        s2 += shfl_xor_f(s2, 32, lane);
        const float rstd = rsqrtf(s2 * (1.0f / 64.0f) + EPS);
        const float* gn = a.in[11] + l * 256 + h * 64;
        const h16* gp = (const h16*)(ws + WS_Z) + (size_t)(b * SEQ + qrow) * DINP + C_RG + h * 64;
#pragma unroll
        for (int mtv = 0; mtv < 2; ++mtv)
#pragma unroll
            for (int i4 = 0; i4 < 4; ++i4) { const int dv = 32 * mtv + 8 * i4 + 4 * hi;
                const half4 gg = *(const half4*)(gp + dv); const f32x4 gnv = *(const f32x4*)(gn + dv); half4 w;
#pragma unroll
                for (int j = 0; j < 4; ++j) w[j] = (h16)(siluf((float)gg[j]) * (oacc[mtv][4 * i4 + j] - mu) * rstd * gnv[j]);
                *(half4*)(Y + 384 + h * 64 + dv) = w; }
    }
}

DI float gelu_tanh(float x) { const float u = 0.7978845608028654f * (x + 0.044715f * x * x * x); const float t = 1.0f - 2.0f * __builtin_amdgcn_rcpf(1.0f + __expf(2.0f * u)); return 0.5f * x * (1.0f + t); }
DI float sigmoidf_(float v) { return __builtin_amdgcn_rcpf(1.0f + __expf(-v)); }
DI float neg_expm1(float x) { const float big = 1.0f - __expf(x); const float sm = -x * (1.0f + x * (0.5f + x * (0.16666667f + x * 0.041666668f))); return (x > -0.1f) ? sm : big; }
DI void lru_unit(const Args& a, int l, int b, int g, LAS unsigned char* lds, const int WID_) {
    const int tid = tid_opaque(WID_), lane = tid & 63, wave = WID_, l32 = lane & 31, hi = lane >> 5;
    unsigned char* ws = a.ws;
    const h16* Z = (const h16*)(ws + WS_Z) + (size_t)b * SEQ * DINP;
    h16* Y = (h16*)(ws + WS_H) + (size_t)b * SEQ * D + 640 + 64 * g + lane;
    const int ch = 64 * g + lane;
    const float cw0 = a.in[12][(l * 4 + 0) * 384 + ch], cw1 = a.in[12][(l * 4 + 1) * 384 + ch], cw2 = a.in[12][(l * 4 + 2) * 384 + ch], cw3 = a.in[12][(l * 4 + 3) * 384 + ch];
    const float cb = a.in[13][l * 384 + ch], ba = a.in[15][l * 384 + ch], bi = a.in[17][l * 384 + ch];
    const float lam = a.in[18][l * 384 + ch];
    const float sp8 = 8.0f * log1pf(expf(-lam));
    const h16* WA = (const h16*)(ws + WS_LRUW) + (size_t)((l * 2 + 0) * 6 + g) * 4096;
    const h16* WI = (const h16*)(ws + WS_LRUW) + (size_t)((l * 2 + 1) * 6 + g) * 4096;
    LAS unsigned char* reg = lds + wave * 16384;
    LAS float* Rb = (LAS float*)reg; LAS float* Ib = (LAS float*)(reg + 8192);
    LAS float* cA = (LAS float*)(lds + 131072); LAS float* cH = (LAS float*)(lds + 131072 + 2048);
    float h_round = 0.f;
    for (int rd = 0; rd < 8; ++rd) {
        const int t0 = rd * 256 + wave * 32;
        h16 gvh[32];
        {
            const h16* ug = Z + C_UG + ch;
#pragma unroll
            for (int t = 0; t < 32; ++t) gvh[t] = ug[(size_t)(t0 + t) * DINP];
        }
        half8 wfa[2][4], wfi[2][4];
#pragma unroll
        for (int nt = 0; nt < 2; ++nt)
#pragma unroll
            for (int s = 0; s < 4; ++s) { wfa[nt][s] = *(const half8*)(WA + (32 * nt + l32) * 64 + 16 * s + 8 * hi); wfi[nt][s] = *(const half8*)(WI + (32 * nt + l32) * 64 + 16 * s + 8 * hi); }
        float xc[32];
        {
            const h16* ux = Z + C_UX + ch;
            float xm3 = 0.f, xm2 = 0.f, xm1 = 0.f;
            if (t0 > 0) { xm3 = (float)ux[(size_t)(t0 - 3) * DINP]; xm2 = (float)ux[(size_t)(t0 - 2) * DINP]; xm1 = (float)ux[(size_t)(t0 - 1) * DINP]; }
            float xv[32];
#pragma unroll
            for (int t = 0; t < 32; ++t) xv[t] = (float)ux[(size_t)(t0 + t) * DINP];
#pragma unroll
            for (int t = 0; t < 32; ++t) { const float v = cb + cw0 * xm3 + cw1 * xm2 + cw2 * xm1 + cw3 * xv[t]; xc[t] = v; xm3 = xm2; xm2 = xm1; xm1 = xv[t];
                *(LAS h16*)(reg + t * 144 + lane * 2) = (h16)v; }
        }
        __syncthreads();
        {
            half8 xa[4];
#pragma unroll
            for (int s = 0; s < 4; ++s) xa[s] = *(const LAS half8*)(reg + l32 * 144 + (16 * s + 8 * hi) * 2);
            f32x16 ra[2], ia[2];
#pragma unroll
            for (int nt = 0; nt < 2; ++nt) {
#pragma unroll
                for (int i = 0; i < 16; ++i) { ra[nt][i] = 0.f; ia[nt][i] = 0.f; }
#pragma unroll
                for (int s = 0; s < 4; ++s) { ra[nt] = __builtin_amdgcn_mfma_f32_32x32x16_f16(xa[s], wfa[nt][s], ra[nt], 0, 0, 0); ia[nt] = __builtin_amdgcn_mfma_f32_32x32x16_f16(xa[s], wfi[nt][s], ia[nt], 0, 0, 0); }
            }
            __syncthreads();
#pragma unroll
            for (int nt = 0; nt < 2; ++nt)
#pragma unroll
                for (int i = 0; i < 16; ++i) { const int t = crow(i, hi); Rb[t * 64 + 32 * nt + l32] = ra[nt][i]; Ib[t * 64 + 32 * nt + l32] = ia[nt][i]; }
        }
        __syncthreads();
        float Ac = 1.f, hl = 0.f;
#pragma unroll
        for (int t = 0; t < 32; ++t) {
            const float ea = 1.0f + __expf(-(Rb[t * 64 + lane] + ba)), ei = 1.0f + __expf(-(Ib[t * 64 + lane] + bi));
            const float rc = __builtin_amdgcn_rcpf(ea * ei);
            const float r = ei * rc, ig = ea * rc;
            const float log_a = -sp8 * r;
            const float av = __expf(log_a);
            const float bv = __builtin_amdgcn_sqrtf(neg_expm1(2.0f * log_a)) * ig * xc[t];
            hl = av * hl + bv; Ac = Ac * av;
            Rb[t * 64 + lane] = Ac; Ib[t * 64 + lane] = hl;
        }
        cA[wave * 64 + lane] = Ac; cH[wave * 64 + lane] = hl;
        __syncthreads();
        float h_in = 0.f, hc = h_round;
#pragma unroll
        for (int w = 0; w < 8; ++w) { if (w == wave) h_in = hc; hc = cA[w * 64 + lane] * hc + cH[w * 64 + lane]; }
        h_round = hc;
        {
#pragma unroll
            for (int t = 0; t < 32; ++t) { const float hv = Ib[t * 64 + lane] + Rb[t * 64 + lane] * h_in; Y[(size_t)(t0 + t) * D] = (h16)(gelu_tanh((float)gvh[t]) * hv); }
        }
        __syncthreads();
    }
}

DI void mixer_phase(const Args& a, int lc, LAS unsigned char* lds, const int WID_) {
    const int l = lc & 3;
    unsigned* ctr = (unsigned*)(a.ws + WS_CTL) + 64 * lc;
    LAS unsigned* su = (LAS unsigned*)(lds + LDS_BYTES - 64);
    constexpr int NLRU = (PROBE_MODE == 6) ? 192 : 96;
    constexpr int NMLA = (PROBE_MODE == 7) ? 192 : 96, NRET = (PROBE_MODE == 8) ? 128 : 64, NSLOT = NMLA + NRET;
    constexpr int NUNITS = NLRU + 8 * NSLOT;
    for (;;) {
        if (tid_opaque(WID_) == 0) *su = atomicAdd(ctr, 1u);
        __syncthreads();
        const int u = (int)*su;
        __syncthreads();
        if (u >= NUNITS) break;
        if (u < NLRU) { const int uu = u % 96; lru_unit(a, l, uu / 6, uu % 6, lds, WID_); }
        else { const int v = u - NLRU, qs = v / NSLOT, w = v - qs * NSLOT, qb = 7 - qs;
            if (w < NMLA) { const int ww = w % 96; attn_unit<false>(a, l, ww / 6, ww % 6, qb, lds, WID_); }
            else { const int r = (w - NMLA) % 64; attn_unit<true>(a, l, r >> 2, r & 3, qb, lds, WID_); } }
        __syncthreads();
    }
}

DI void grid_bar(unsigned* ctr, unsigned target, const int WID_) {
    asm volatile("s_waitcnt vmcnt(0) lgkmcnt(0)" ::: "memory");
    __syncthreads();
    if (tid_opaque(WID_) == 0) {
        __builtin_amdgcn_fence(__ATOMIC_RELEASE, "agent");
        asm volatile("s_waitcnt vmcnt(0)" ::: "memory");
        (void)__hip_atomic_fetch_add(ctr, 1u, __ATOMIC_RELAXED, __HIP_MEMORY_SCOPE_AGENT);
        while (__hip_atomic_load(ctr, __ATOMIC_RELAXED, __HIP_MEMORY_SCOPE_AGENT) < target) __builtin_amdgcn_s_sleep(1);
        __builtin_amdgcn_fence(__ATOMIC_ACQUIRE, "agent");
        asm volatile("s_waitcnt vmcnt(0)" ::: "memory");
    }
    __syncthreads();
}

DI void grid_bar2(unsigned* ctl, unsigned k, unsigned x, unsigned nx, unsigned nxcd, const int WID_) {
    asm volatile("s_waitcnt vmcnt(0) lgkmcnt(0)" ::: "memory");
    __syncthreads();
    if (tid_opaque(WID_) == 0) {
        unsigned* A = ctl + 520 + 16 * x; unsigned* GC = ctl + 656; unsigned* R = ctl + 704 + 16 * x;
        const unsigned old = __hip_atomic_fetch_add(A, 1u, __ATOMIC_RELAXED, __HIP_MEMORY_SCOPE_AGENT);
        unsigned sp = 0;
        if (old + 1u == k * nx) {
            __builtin_amdgcn_fence(__ATOMIC_RELEASE, "agent");
            asm volatile("s_waitcnt vmcnt(0)" ::: "memory");
            (void)__hip_atomic_fetch_add(GC, 1u, __ATOMIC_RELAXED, __HIP_MEMORY_SCOPE_AGENT);
        }
        (void)R;
        while (__hip_atomic_load(GC, __ATOMIC_RELAXED, __HIP_MEMORY_SCOPE_AGENT) < k * nxcd) { __builtin_amdgcn_s_sleep(1); if (++sp > (1u << 22)) break; }
        __builtin_amdgcn_fence(__ATOMIC_ACQUIRE, "agent");
        asm volatile("s_waitcnt vmcnt(0)" ::: "memory");
    }
    __syncthreads();
}

__global__ void __launch_bounds__(NTHREADS, 2) hymba_fwd(Args a_unused) {
    extern __shared__ __attribute__((aligned(16))) unsigned char lds_raw[];
    LAS unsigned char* lds = (LAS unsigned char*)lds_raw;
    cg::grid_group grid = cg::this_grid();
    const int WID_ = __builtin_amdgcn_readfirstlane((int)(threadIdx.x >> 6));
    int l = 0, nbar = 0;
    const unsigned XCC_ = (unsigned)__builtin_amdgcn_s_getreg((3 << 11) | 20) & 7u;
    if (threadIdx.x == 0) (void)__hip_atomic_fetch_add((unsigned*)(args_opaque()->ws + WS_CTL) + 832 + 16 * XCC_, 1u, __ATOMIC_RELAXED, __HIP_MEMORY_SCOPE_AGENT);
    unsigned NX_ = 0, NXCD_ = 0;
#define PHASE_BEGIN(KIND) { const int nrep = (PROBE_MODE != 0 && PROBE_MODE == (KIND)) ? 2 : 1; for (int rep = 0; rep < nrep; ++rep) { const ArgsP ap = args_opaque(); const int BID = bid_opaque(), G = gdim_opaque(); (void)BID; (void)G; const Args a = load_args(ap); unsigned char* ws = a.ws; const float* modv = (const float*)(ws + WS_MOD); const float* modl = modv + (size_t)l * 16 * 6144; h16* XH = (h16*)(ws + WS_XH); float* RSS = (float*)(ws + WS_RSS); (void)RSS; \
    h16* H = (h16*)(ws + WS_H); h16* Z = (h16*)(ws + WS_Z); h16* HID = (h16*)(ws + WS_HID); (void)modl; (void)XH; (void)H; (void)Z; (void)HID;
#define PHASE_END_(LAST)   if (rep + 1 < nrep || !LAST) { if (gdim_opaque() == 0x7fffffff) grid.sync(); ++nbar; \
        if (nbar == 1) { grid_bar((unsigned*)(args_opaque()->ws + WS_CTL) + 512, (unsigned)gdim_opaque(), WID_); \
            unsigned* cen = (unsigned*)(args_opaque()->ws + WS_CTL) + 832; unsigned nn = 0; \
            for (int xx = 0; xx < 8; ++xx) { const unsigned cv = __hip_atomic_load(cen + 16 * xx, __ATOMIC_RELAXED, __HIP_MEMORY_SCOPE_AGENT); nn += cv ? 1u : 0u; if ((unsigned)xx == XCC_) NX_ = cv; } \
            NX_ = __builtin_amdgcn_readfirstlane(NX_); NXCD_ = __builtin_amdgcn_readfirstlane(nn); } \
        else grid_bar2((unsigned*)(args_opaque()->ws + WS_CTL), (unsigned)(nbar - 1), XCC_, NX_, NXCD_, WID_); } \
    if (PROBE_MODE == 5) { ++nbar; grid_bar2((unsigned*)(args_opaque()->ws + WS_CTL), (unsigned)(nbar - 1), XCC_, NX_, NXCD_, WID_); } } }
#define PHASE_END PHASE_END_(false)

    PHASE_BEGIN(1) p0_prologue(a, lds, WID_); PHASE_END
    PHASE_BEGIN(0) p0b_phase(a, lds, WID_); PHASE_END

    for (l = 0; l < DEPTH; ++l) {
        PHASE_BEGIN(2) { pg8::Gemm g{H, (const h16*)(ws + WS_WIN + l * WIN_STRIDE), T, DINP, D}; pg8::StaticOrder S; S.init(T, DINP, G, BID, D);
            EpiZ E{Z, DINP, RSS + (size_t)(2 * l) * T, (const float*)(ws + WS_B1) + (size_t)l * 16 * DINP, DINP}; pg8::gemm_phase<EpiZ, GEMM_ALIGN, GEMM_SP2>(lds, g, S, E, WID_); } PHASE_END
        PHASE_BEGIN(2) prep_phase(a, l, WID_); PHASE_END
        PHASE_BEGIN(2) { pg8::Gemm g{(const h16*)(ws + WS_CQKV), (const h16*)(ws + WS_WUP + l * WUP_STRIDE), T, NUP, KUP}; pg8::StaticOrder S; S.init(T, NUP, G, BID, KUP, 1);
            EpiF16 E{(h16*)(ws + WS_UP), NUP}; pg8::gemm_phase<EpiF16, GEMM_ALIGN, GEMM_SP2>(lds, g, S, E, WID_); } PHASE_END
        PHASE_BEGIN(3) mixer_phase(a, l + 4 * rep, lds, WID_); PHASE_END
#if PROBE_MODE == 9
        PHASE_BEGIN(0) { pg8::Gemm g{H, (const h16*)(ws + WS_WOUT + l * WOUT_STRIDE), T, D, D}; pg8::StaticOrder S; S.init(T, D, G, BID, D);
            EpiNull E{(float*)(ws + WS_CTL) + 768}; pg8::gemm_phase<EpiNull, GEMM_ALIGN, GEMM_SP2>(lds, g, S, E, WID_); } PHASE_END
#endif
        PHASE_BEGIN(0) { pg8::Gemm g{H, (const h16*)(ws + WS_WOUT + l * WOUT_STRIDE), T, D, D}; pg8::StaticOrder S; S.init(T, D, G, BID, D);
            EpiRes E{XH, modl + 2 * D, 6144, (h16*)(ws + WS_XG2), a.in[20] + l * D, modl + 4 * D, RSS + (size_t)(2 * l + 1) * T}; pg8::gemm_phase<EpiRes, GEMM_ALIGN, GEMM_SP2>(lds, g, S, E, WID_); } PHASE_END
        PHASE_BEGIN(4) { pg8::Gemm g{(const h16*)(ws + WS_XG2), (const h16*)(ws + WS_WGU + l * WGU_STRIDE), T, 2 * FFN, D}; pg8::StaticOrder S; S.init(T, 2 * FFN, G, BID, D);
            EpiSwiGLU E{HID, FFN, RSS + (size_t)(2 * l + 1) * T, (const float*)(ws + WS_B2) + (size_t)l * 16 * 2 * FFN}; pg8::gemm_phase<EpiSwiGLU, GEMM_ALIGN, GEMM_SP2>(lds, g, S, E, WID_); } PHASE_END
#if PROBE_MODE == 10
        PHASE_BEGIN(0) { pg8::Gemm g{HID, (const h16*)(ws + WS_WDN + l * WDN_STRIDE), T, D, FFN}; pg8::StaticOrder S; S.init(T, D, G, BID, FFN);
            EpiNull E{(float*)(ws + WS_CTL) + 768}; pg8::gemm_phase<EpiNull, GEMM_ALIGN, GEMM_SP2>(lds, g, S, E, WID_); } PHASE_END
#endif
        PHASE_BEGIN(0) { pg8::Gemm g{HID, (const h16*)(ws + WS_WDN + l * WDN_STRIDE), T, D, FFN}; pg8::StaticOrder S; S.init(T, D, G, BID, FFN);
            const int ln = (l + 1 < DEPTH) ? l + 1 : l;
            EpiRes E{XH, modl + 5 * D, 6144, (l + 1 < DEPTH) ? H : (h16*)nullptr, a.in[5] + ln * D, modv + (size_t)ln * 16 * 6144 + 1 * D, RSS + (size_t)(2 * l + 2) * T}; pg8::gemm_phase<EpiRes, GEMM_ALIGN, GEMM_SP2>(lds, g, S, E, WID_); } PHASE_END
    }
    PHASE_BEGIN(0) final_phase(a, WID_); PHASE_END_(true)
#undef PHASE_BEGIN
#undef PHASE_END
#undef PHASE_END_
}

extern "C" void kernel_launch(void* const* d_in, const int* in_sizes, int n_in, void* d_out, int out_size, void* d_ws, size_t ws_size, hipStream_t stream) {
    static int grid = 0;
    if (grid == 0) {
        if (n_in != 26 || out_size != T * D || ws_size < WS_END) { fprintf(stderr, "kernel_launch: unexpected shapes (n_in %d out %d ws %zu)\n", n_in, out_size, ws_size); grid = -1; return; }
        int dev = 0, cus = 0, per_cu = 0;
        hipGetDevice(&dev); hipDeviceGetAttribute(&cus, hipDeviceAttributeMultiprocessorCount, dev);
        if (hipFuncSetAttribute((const void*)hymba_fwd, hipFuncAttributeMaxDynamicSharedMemorySize, LDS_BYTES) != hipSuccess) { fprintf(stderr, "kernel_launch: hipFuncSetAttribute failed\n"); grid = -1; return; }
        if (hipOccupancyMaxActiveBlocksPerMultiprocessor(&per_cu, (const void*)hymba_fwd, NTHREADS, LDS_BYTES) != hipSuccess || per_cu < 1) { fprintf(stderr, "kernel_launch: occupancy query gave %d\n", per_cu); per_cu = 1; }
        (void)hipGetLastError();
        grid = cus * 1;
    }
    if (grid < 0) return;
    hipMemsetAsync((char*)d_ws + WS_CTL, 0, CTL_BYTES, stream);
    Args a{};
    for (int i = 0; i < 26; ++i) a.in[i] = (const float*)d_in[i];
    a.out = (float*)d_out; a.ws = (unsigned char*)d_ws; a.ph_lo = 0; a.ph_hi = 1 << 20;
    void* kargs[] = {&a};
    hipError_t e = hipLaunchCooperativeKernel((const void*)hymba_fwd, dim3(grid), dim3(NTHREADS), kargs, LDS_BYTES, stream);
    if (e != hipSuccess) fprintf(stderr, "kernel_launch: cooperative launch failed: %s (grid %d)\n", hipGetErrorString(e), grid);
}
```
